# Optimizing an MI355X kernel written in HIP

```python
import math
import jax, jax.numpy as jnp
from jax import lax
import numpy as np

D_MODEL = 1024
BATCH = 4
SEQ = 4096
DEPTH = 1

D_MIX = 2 * D_MODEL
SSM_D = D_MIX // 2
SSM_HEAD_DIM = 64
SSM_HEADS = SSM_D // SSM_HEAD_DIM
SSM_GROUPS = 2
SSM_STATE = 128
SSM_CONV = 4
SSM_CHUNK = 128
SSM_CONV_DIM = SSM_D + 2 * SSM_GROUPS * SSM_STATE
GLA_DV = D_MIX - SSM_D
GLA_HEADS = 4
GLA_HEAD_V = GLA_DV // GLA_HEADS
GLA_DK = GLA_DV // 2
GLA_HEAD_K = GLA_DK // GLA_HEADS
GLA_GATE_RANK = 16
GLA_GATE_NORM = 16.0
GLA_CHUNK = 64
N_EXPERTS = 32
TOP_K = 4
D_EXPERT = D_MODEL
SWIGLU_LIMIT = 7.0
SWIGLU_ALPHA = 1.702
MOE_BLOCK = 128
N_MOD = 6
EPS = 1e-6
IN_SIZES = (SSM_D, SSM_CONV_DIM, SSM_HEADS, GLA_DK, GLA_DK, GLA_DV, GLA_GATE_RANK, GLA_DV)
IN_COLS = SSM_D + SSM_CONV_DIM + SSM_HEADS + 2 * GLA_DK + GLA_DV + GLA_GATE_RANK + GLA_DV

kernel_name = 'hybrid_ssd_gla_moe_block'


def rms_norm(x, g):
    xf = x.astype(jnp.float32)
    y = xf * lax.rsqrt(jnp.mean(xf * xf, axis=-1, keepdims=True) + EPS)
    return (y * g.astype(jnp.float32)).astype(x.dtype)


def grouped_rms_norm(y, g, n_groups):
    shp = y.shape
    yg = y.astype(jnp.float32).reshape(shp[:-1] + (n_groups, shp[-1] // n_groups))
    yg = yg * lax.rsqrt(jnp.mean(yg * yg, axis=-1, keepdims=True) + EPS)
    return (yg.reshape(shp) * g.astype(jnp.float32)).astype(y.dtype)


def modulate(h, shift, scale):
    return h * (1.0 + scale[:, None, :]) + shift[:, None, :]


def causal_depthwise_conv(u, w, b):
    k = w.shape[0]
    out = lax.conv_general_dilated(
        u, w[:, None, :], window_strides=(1,), padding=[(k - 1, 0)],
        dimension_numbers=('NWC', 'WIO', 'NWC'), feature_group_count=u.shape[-1])
    return out + b


def chunk_state_scan(states, decays):
    def step(prev, inp):
        st, dec = inp
        return prev * dec + st, prev
    init = jnp.zeros(states.shape[:1] + states.shape[2:], jnp.float32)
    _, prev = lax.scan(step, init, (jnp.moveaxis(states, 1, 0), jnp.moveaxis(decays, 1, 0)))
    return jnp.moveaxis(prev, 0, 1)


def ssd_chunked(xh, dt, a, bm, cm):
    bsz, s, h, p = xh.shape
    g, n = bm.shape[-2:]
    l = SSM_CHUNK
    nc = s // l
    hpg = h // g
    f32 = jnp.float32
    dtc = dt.astype(f32).reshape(bsz, nc, l, h)
    xdt = xh.astype(f32).reshape(bsz, nc, l, h, p) * dtc[..., None]
    bm = bm.astype(f32).reshape(bsz, nc, l, g, n)
    cm = cm.astype(f32).reshape(bsz, nc, l, g, n)
    cs = jnp.cumsum(dtc * a.astype(f32), axis=2)
    cs_h = jnp.moveaxis(cs, 3, 2)
    causal = jnp.tril(jnp.ones((l, l), bool))
    decay = jnp.exp(jnp.where(causal, cs_h[..., :, None] - cs_h[..., None, :], -jnp.inf))
    cb = jnp.repeat(jnp.einsum('bclgn,bcsgn->bcgls', cm, bm), hpg, axis=2)
    y_diag = jnp.einsum('bchls,bcshp->bclhp', cb * decay, xdt)
    bm_h = jnp.repeat(bm, hpg, axis=3)
    cm_h = jnp.repeat(cm, hpg, axis=3)
    decay_to_end = jnp.exp(cs[:, :, -1:, :] - cs)
    states = jnp.einsum('bclhn,bclh,bclhp->bchpn', bm_h, decay_to_end, xdt)
    chunk_decay = jnp.exp(cs[:, :, -1, :])[..., None, None]
    prev = chunk_state_scan(states, chunk_decay)
    y_off = jnp.einsum('bclhn,bchpn,bclh->bclhp', cm_h, prev, jnp.exp(cs))
    return (y_diag + y_off).reshape(bsz, s, h, p)


def gla_chunked(q, k, v, gk):
    bsz, s, h, dk = q.shape
    dv = v.shape[-1]
    l = GLA_CHUNK
    nc = s // l
    f32 = jnp.float32
    q = q.astype(f32).reshape(bsz, nc, l, h, dk) * (dk ** -0.5)
    k = k.astype(f32).reshape(bsz, nc, l, h, dk)
    v = v.astype(f32).reshape(bsz, nc, l, h, dv)
    bcum = jnp.cumsum(gk.astype(f32).reshape(bsz, nc, l, h, dk), axis=2)
    q_t = q * jnp.exp(bcum)
    k_t = k * jnp.exp(-bcum)
    causal = jnp.tril(jnp.ones((l, l), bool))
    att = jnp.where(causal, jnp.einsum('bclhk,bcshk->bchls', q_t, k_t), 0.0)
    o_intra = jnp.einsum('bchls,bcshv->bclhv', att, v)
    b_last = bcum[:, :, -1:]
    states = jnp.einsum('bclhk,bclhv->bchkv', k * jnp.exp(b_last - bcum), v)
    chunk_decay = jnp.exp(b_last[:, :, 0])[..., None]
    prev = chunk_state_scan(states, chunk_decay)
    o_inter = jnp.einsum('bclhk,bchkv->bclhv', q_t, prev)
    return (o_intra + o_inter).reshape(bsz, s, h, dv)


def hybrid_mixer(h, w_in, conv_w, conv_b, dt_bias, a_log, d_skip, ssm_norm_g,
                 gla_wg2, gla_bg, gla_norm_g, w_out):
    bsz, s, _ = h.shape
    proj = h @ w_in
    split_idx = np.cumsum(IN_SIZES)[:-1].tolist()
    z, xbc, dt_raw, q, k, v, g_low, r = jnp.split(proj, split_idx, axis=-1)
    xbc = jax.nn.silu(causal_depthwise_conv(xbc, conv_w, conv_b))
    xs, bm, cm = jnp.split(xbc, [SSM_D, SSM_D + SSM_GROUPS * SSM_STATE], axis=-1)
    dt = jax.nn.softplus(dt_raw.astype(jnp.float32) + dt_bias.astype(jnp.float32))
    a = -jnp.exp(a_log.astype(jnp.float32))
    xh = xs.reshape(bsz, s, SSM_HEADS, SSM_HEAD_DIM)
    y = ssd_chunked(xh, dt, a,
                    bm.reshape(bsz, s, SSM_GROUPS, SSM_STATE),
                    cm.reshape(bsz, s, SSM_GROUPS, SSM_STATE))
    y = y + d_skip.astype(jnp.float32)[:, None] * xh.astype(jnp.float32)
    y = y.reshape(bsz, s, SSM_D).astype(h.dtype) * jax.nn.silu(z)
    y = grouped_rms_norm(y, ssm_norm_g, SSM_GROUPS)
    gk = jax.nn.log_sigmoid((g_low @ gla_wg2 + gla_bg).astype(jnp.float32)) / GLA_GATE_NORM
    o = gla_chunked(q.reshape(bsz, s, GLA_HEADS, GLA_HEAD_K),
                    k.reshape(bsz, s, GLA_HEADS, GLA_HEAD_K),
                    v.reshape(bsz, s, GLA_HEADS, GLA_HEAD_V),
                    gk.reshape(bsz, s, GLA_HEADS, GLA_HEAD_K)).astype(h.dtype)
    o = rms_norm(o, gla_norm_g) * jax.nn.silu(r.reshape(bsz, s, GLA_HEADS, GLA_HEAD_V))
    o = o.reshape(bsz, s, GLA_DV)
    return jnp.concatenate([y, o], axis=-1) @ w_out


def expert_swiglu(xb, wg, bg, wu, bu, wd, bd):
    gate = jnp.minimum(xb @ wg + bg, SWIGLU_LIMIT)
    up = jnp.clip(xb @ wu + bu, -SWIGLU_LIMIT, SWIGLU_LIMIT)
    glu = gate * jax.nn.sigmoid(SWIGLU_ALPHA * gate)
    return ((up + 1.0) * glu) @ wd + bd


def moe_ffn(t, w_router, b_router, w_gate, b_gate, w_up, b_up, w_down, b_down):
    n_tok, d = t.shape
    logits = (t @ w_router + b_router).astype(jnp.float32)
    topv, topi = lax.top_k(logits, TOP_K)
    topw = jax.nn.softmax(topv, axis=-1)
    n_asg = n_tok * TOP_K
    e_flat = topi.reshape(-1)
    tok_flat = jnp.repeat(jnp.arange(n_tok, dtype=jnp.int32), TOP_K)
    w_flat = topw.reshape(-1)
    order = jnp.argsort(e_flat)
    e_sorted = e_flat[order]
    counts = jnp.bincount(e_flat, length=N_EXPERTS)
    padded = (counts + MOE_BLOCK - 1) // MOE_BLOCK * MOE_BLOCK
    start = jnp.cumsum(counts) - counts
    pend = jnp.cumsum(padded)
    pstart = pend - padded
    dest = pstart[e_sorted] + jnp.arange(n_asg, dtype=jnp.int32) - start[e_sorted]
    n_blocks = -(-n_asg // MOE_BLOCK) + N_EXPERTS
    n_rows = n_blocks * MOE_BLOCK
    row_tok = jnp.zeros((n_rows,), jnp.int32).at[dest].set(tok_flat[order])
    row_w = jnp.zeros((n_rows,), jnp.float32).at[dest].set(w_flat[order])
    block_start = jnp.arange(n_blocks, dtype=jnp.int32) * MOE_BLOCK
    block_e = jnp.minimum(jnp.searchsorted(pend, block_start, side='right'), N_EXPERTS - 1)

    def run_block(args):
        toks, e = args
        return expert_swiglu(t[toks], w_gate[e], b_gate[e], w_up[e], b_up[e], w_down[e], b_down[e])

    y_rows = lax.map(run_block, (row_tok.reshape(n_blocks, MOE_BLOCK), block_e))
    y_rows = y_rows.reshape(n_rows, d).astype(jnp.float32) * row_w[:, None]
    return jax.ops.segment_sum(y_rows, row_tok, num_segments=n_tok).astype(t.dtype)


def _normal(key, shape, scale):
    return scale * jax.random.normal(key, shape, jnp.float32)


def setup_inputs(seed: int = 0) -> dict:
    key = jax.random.key(seed)
    ks = jax.random.split(key, 28)
    L, D, F, E = DEPTH, D_MODEL, D_EXPERT, N_EXPERTS
    gate_offset = jnp.zeros((N_MOD, D), jnp.float32).at[jnp.array([2, 5])].set(1.0).reshape(-1)
    dt0 = jnp.exp(jax.random.uniform(ks[8], (L, SSM_HEADS), jnp.float32,
                                     math.log(1e-3), math.log(1e-1)))
    return {
        'x': _normal(ks[0], (BATCH, SEQ, D), 1.0),
        'c': _normal(ks[1], (BATCH, D), 1.0),
        'w_ada': _normal(ks[2], (L, D, N_MOD * D), 0.5 * D ** -0.5),
        'b_ada': _normal(ks[3], (L, N_MOD * D), 0.02) + gate_offset,
        'norm1_g': 1.0 + _normal(ks[4], (L, D), 0.02),
        'w_in': _normal(ks[5], (L, D, IN_COLS), D ** -0.5),
        'conv_w': _normal(ks[6], (L, SSM_CONV, SSM_CONV_DIM), SSM_CONV ** -0.5),
        'conv_b': _normal(ks[7], (L, SSM_CONV_DIM), 0.02),
        'dt_bias': dt0 + jnp.log(-jnp.expm1(-dt0)),
        'a_log': jnp.log(jax.random.uniform(ks[9], (L, SSM_HEADS), jnp.float32, 1.0, 16.0)),
        'd_skip': 1.0 + _normal(ks[10], (L, SSM_HEADS), 0.02),
        'ssm_norm_g': 1.0 + _normal(ks[11], (L, SSM_D), 0.02),
        'gla_wg2': _normal(ks[12], (L, GLA_GATE_RANK, GLA_DK), GLA_GATE_RANK ** -0.5),
        'gla_bg': _normal(ks[13], (L, GLA_DK), 0.02),
        'gla_norm_g': 1.0 + _normal(ks[14], (L, GLA_HEAD_V), 0.02),
        'w_out': _normal(ks[15], (L, D_MIX, D), D_MIX ** -0.5),
        'norm2_g': 1.0 + _normal(ks[16], (L, D), 0.02),
        'w_router': _normal(ks[17], (L, D, E), D ** -0.5),
        'b_router': _normal(ks[18], (L, E), 0.01),
        'w_gate': _normal(ks[19], (L, E, D, F), D ** -0.5),
        'b_gate': _normal(ks[20], (L, E, F), 0.01),
        'w_up': _normal(ks[21], (L, E, D, F), D ** -0.5),
        'b_up': _normal(ks[22], (L, E, F), 0.01),
        'w_down': _normal(ks[23], (L, E, F, D), F ** -0.5),
        'b_down': _normal(ks[24], (L, E, D), 0.01),
        'final_norm_g': 1.0 + _normal(ks[25], (D,), 0.02),
    }


def reference(x, c, w_ada, b_ada, norm1_g, w_in, conv_w, conv_b, dt_bias, a_log, d_skip,
              ssm_norm_g, gla_wg2, gla_bg, gla_norm_g, w_out, norm2_g, w_router, b_router,
              w_gate, b_gate, w_up, b_up, w_down, b_down, final_norm_g):
    bsz, s, d = x.shape
    cond = jax.nn.silu(c)
    for l in range(DEPTH):
        mod = cond @ w_ada[l] + b_ada[l]
        sh1, sc1, gt1, sh2, sc2, gt2 = jnp.split(mod, N_MOD, axis=-1)
        h = modulate(rms_norm(x, norm1_g[l]), sh1, sc1)
        mix = hybrid_mixer(h, w_in[l], conv_w[l], conv_b[l], dt_bias[l], a_log[l], d_skip[l],
                           ssm_norm_g[l], gla_wg2[l], gla_bg[l], gla_norm_g[l], w_out[l])
        x = x + gt1[:, None, :] * mix
        h = modulate(rms_norm(x, norm2_g[l]), sh2, sc2)
        ffn = moe_ffn(h.reshape(bsz * s, d), w_router[l], b_router[l], w_gate[l], b_gate[l],
                      w_up[l], b_up[l], w_down[l], b_down[l]).reshape(bsz, s, d)
        x = x + gt2[:, None, :] * ffn
    return rms_norm(x, final_norm_g)
```

```cpp
#include <hip/hip_runtime.h>
#include <cstdio>

#ifndef MK_N_LAUNCHES
#define MK_N_LAUNCHES 1
#endif

#ifndef SLAB_FP8
#define SLAB_FP8 1
#endif
#ifndef MOE_FP8
#define MOE_FP8 1
#endif
#define GAS __attribute__((address_space(1)))
#define LAS __attribute__((address_space(3)))
typedef unsigned short bf16;
typedef unsigned v4u __attribute__((ext_vector_type(4)));
typedef unsigned v2u __attribute__((ext_vector_type(2)));
typedef float f32x4 __attribute__((ext_vector_type(4)));
typedef short bf16x8 __attribute__((ext_vector_type(8)));
typedef int v4i __attribute__((ext_vector_type(4)));
typedef int v8i __attribute__((ext_vector_type(8)));
#define RLX_AGENT __ATOMIC_RELAXED, __HIP_MEMORY_SCOPE_AGENT
#define LDS_WAIT() asm volatile("s_waitcnt lgkmcnt(0)" ::: "memory")
#define VM_WAIT() asm volatile("s_waitcnt vmcnt(0)" ::: "memory")

constexpr int NB = 4, SEQ = 4096, T = NB * SEQ, D = 1024;
constexpr int NIN = 5888;
constexpr int PZ = 0, PX = 1024, PBM = 2048, PCM = 2304, PQ = 2560, PK = 3072, PV = 3584, PR = 4608, PDT = 5632, PGL = 5648;
constexpr int NE = 32, TOPK = 4, LCAP = 16384;
constexpr int MAXTILES = 288;
constexpr float EPS = 1e-6f;

constexpr size_t MiB = 1u << 20;
constexpr size_t WS_CTL = 0, CTL_ZERO_BYTES = 65536;
constexpr size_t WS_MOD = 65536;
constexpr size_t WS_ROWW = 262144;
constexpr size_t WS_WIN = 1 * MiB, WS_WOUT = 13 * MiB;
constexpr size_t WS_H = 17 * MiB;
constexpr size_t WS_PROJ = 49 * MiB;
constexpr size_t WS_GK = 281 * MiB;
constexpr size_t WS_DT = 313 * MiB;
constexpr size_t WS_YPRE = 314 * MiB;
constexpr size_t WS_MIX = 442 * MiB;
constexpr size_t WS_SS = 314 * MiB;
constexpr size_t WS_GS = 346 * MiB;
constexpr size_t WS_SW = 417 * MiB;
constexpr size_t WS_SCD = 418 * MiB;
constexpr size_t WS_X1B = 442 * MiB;
constexpr size_t WS_KD = 419 * MiB;
constexpr size_t WS_DKL = 435 * MiB;
constexpr size_t WS_CD = 410 * MiB;
constexpr size_t WS_GD = 410 * MiB + 65536;
constexpr size_t WS_H2 = 49 * MiB;
__host__ __device__ constexpr size_t w1_off(int e) { return (e < 24 ? (size_t)(233 + 2 * e) : (size_t)(17 + 2 * (e - 24))) * MiB; }
__host__ __device__ constexpr size_t w2_off(int e) { return (e < 16 ? (size_t)(33 + e) : e < 28 ? (size_t)(1 + (e - 16)) : (size_t)(411 + (e - 28))) * MiB; }
constexpr size_t WS_ACT = 65 * MiB;
constexpr size_t WS_SLAB = 281 * MiB;
constexpr size_t WS_LIST = 415 * MiB;
constexpr size_t WS_END = 506 * MiB;
constexpr int CW_BAR = 1024;
constexpr int CW_CVT = 6144;
constexpr int CW_CNT = 8192, CNT_STRIDE = 128;

constexpr int RING_BYTES = 131072;
constexpr int LDS_BYTES = 163840;
constexpr int TAB_OFF = LDS_BYTES - 1024;
constexpr int MISC_OFF = LDS_BYTES - 256;
constexpr int WR_STRIDE = 36;

typedef __bf16 bf16x2_t __attribute__((ext_vector_type(2)));
typedef float f32x2_t __attribute__((ext_vector_type(2)));
__device__ __forceinline__ unsigned pk2(float lo, float hi) { const f32x2_t v = {lo, hi}; return __builtin_bit_cast(unsigned, __builtin_convertvector(v, bf16x2_t)); }
__device__ __forceinline__ unsigned f2bf(float f) { return pk2(f, f) & 0xffffu; }
__device__ __forceinline__ float bf2f(unsigned b) { return __builtin_bit_cast(float, b << 16); }
__device__ __forceinline__ float bflo(unsigned w) { return __builtin_bit_cast(float, w << 16); }
__device__ __forceinline__ float bfhi(unsigned w) { return __builtin_bit_cast(float, w & 0xffff0000u); }
__device__ __forceinline__ unsigned pk4_fp8(float a, float b, float c, float d) { int p = __builtin_amdgcn_cvt_pk_fp8_f32(a, b, 0, false); p = __builtin_amdgcn_cvt_pk_fp8_f32(c, d, p, true); return (unsigned)p; }
__device__ __forceinline__ float wave_sum(float v) {
#pragma unroll
    for (int o = 1; o < 64; o <<= 1) v += __shfl_xor(v, o);
    return v;
}
__device__ __forceinline__ float silu_f(float x) { return x * __builtin_amdgcn_rcpf(1.f + __expf(-x)); }
__device__ __forceinline__ float softplus_f(float x) { return fmaxf(x, 0.f) + __logf(1.f + __expf(-fabsf(x))); }
__device__ __forceinline__ float logsigmoid_f(float x) { return fminf(x, 0.f) - __logf(1.f + __expf(-fabsf(x))); }

#define XB_TMO      128
#define XB_XCNT(j)  (256  + 64 * (j))
#define XB_XSUB(j)  (1280 + 64 * (j))
#define XB_XGEN(j)  (2304 + 64 * (j))
#define XB_TOP      3328
#define XB_TOPGEN   3392
#define XCD_BAR_WORDS 3456
#define XB_SPIN_CAP (1u << 21)
__device__ __forceinline__ unsigned xb_ld(unsigned* p)              { return __hip_atomic_load(p, __ATOMIC_RELAXED, __HIP_MEMORY_SCOPE_AGENT); }
__device__ __forceinline__ unsigned xb_add(unsigned* p, unsigned v) { return __hip_atomic_fetch_add(p, v, __ATOMIC_RELAXED, __HIP_MEMORY_SCOPE_AGENT); }
__device__ __forceinline__ unsigned xb_xcc_id() { return (unsigned)__builtin_amdgcn_s_getreg((3 << 11) | 20) & 0xFu; }
#define XB_SPIN(cond, bar) do { unsigned _sp = 0; while (cond) { __builtin_amdgcn_s_sleep(1); \
    if ((++_sp & 255u) == 0u) { if (xb_ld(&(bar)[XB_TMO])) break; if (_sp > XB_SPIN_CAP) { atomicAdd(&(bar)[XB_TMO], 1u); break; } } } } while (0)
struct XcdBarrier { unsigned* bar; unsigned x; volatile LAS unsigned* st; };
__device__ __forceinline__ XcdBarrier xcd_barrier_post(unsigned* bar, volatile LAS unsigned* st) {
    XcdBarrier b; b.bar = bar; b.x = xb_xcc_id(); b.st = st;
    if (threadIdx.x == 0) (void)xb_add(&bar[XB_XCNT(b.x)], 1u);
    return b;
}
__device__ __forceinline__ void xcd_barrier_complete(unsigned* bar, unsigned x, unsigned& nloc, unsigned& nx) {
    const unsigned G = gridDim.x * gridDim.y * gridDim.z;
    unsigned sum, cnt, mine, sp = 0u;
    for (;;) {
        sum = 0u; cnt = 0u; mine = 0u;
#pragma unroll
        for (unsigned j = 0; j < 16; ++j) { const unsigned c = xb_ld(&bar[XB_XCNT(j)]); sum += c; cnt += (c > 0u) ? 1u : 0u; mine = (j == x) ? c : mine; }
        if (sum == G) break;
        __builtin_amdgcn_s_sleep(1);
        if ((++sp & 255u) == 0u) { if (xb_ld(&bar[XB_TMO])) break; if (sp > XB_SPIN_CAP) { atomicAdd(&bar[XB_TMO], 1u); break; } }
    }
    nloc = mine > 0u ? mine : 1u; nx = cnt > 0u ? cnt : 1u;
}
__device__ __forceinline__ void xcd_barrier(const XcdBarrier& b) {
    asm volatile("s_waitcnt vmcnt(0)" ::: "memory");
    __syncthreads();
    if (threadIdx.x == 0) {
        unsigned* bar = b.bar;
        __builtin_amdgcn_s_waitcnt(0);
        unsigned nloc = b.st[0], nx = b.st[1];
        if (nloc == 0u) { xcd_barrier_complete(bar, b.x, nloc, nx); b.st[0] = nloc; b.st[1] = nx; }
        const unsigned old = xb_add(&bar[XB_XSUB(b.x)], 1u);
        const unsigned gen = old / nloc;
        if (old + 1u == (gen + 1u) * nloc) {
            __builtin_amdgcn_fence(__ATOMIC_RELEASE, "agent");
            asm volatile("s_waitcnt vmcnt(0)" ::: "memory");
            const unsigned og = xb_add(&bar[XB_TOP], 1u);
            const unsigned tg = og / nx;
            if (og + 1u == (tg + 1u) * nx) xb_add(&bar[XB_TOPGEN], 1u);
            else XB_SPIN(xb_ld(&bar[XB_TOPGEN]) == tg, bar);
            __builtin_amdgcn_fence(__ATOMIC_ACQUIRE, "agent");
            xb_add(&bar[XB_XGEN(b.x)], 1u);
            asm volatile("s_waitcnt vmcnt(0)" ::: "memory");
        } else {
            XB_SPIN(xb_ld(&bar[XB_XGEN(b.x)]) == gen, bar);
            __builtin_amdgcn_fence(__ATOMIC_ACQUIRE, "agent");
            asm volatile("s_waitcnt vmcnt(0)" ::: "memory");
        }
    }
    __syncthreads();
}

namespace pg8 {
constexpr int BM = 256, BK = 64, HALF = 128, HTB = HALF * BK * 2, STAGE_BYTES = 8 * HTB;
__device__ __forceinline__ int lds_byte(int r, int c) { const int st = (r >> 4) * 2 + (c >> 5), rr = r & 15, cc = c & 31, ob = rr * 64 + cc * 2; return st * 1024 + (ob ^ (((ob >> 9) & 1) << 5)); }
__device__ __forceinline__ void stage_rc(int b, int& R, int& C) { const int st = b / 1024, sb = b % 1024, swz = sb ^ (((sb >> 9) & 1) << 5); R = (st >> 1) * 16 + swz / 64; C = (st & 1) * 32 + (swz % 64) / 2; }
__device__ __forceinline__ int perm32(int rho) { const int n = rho >> 4, i = rho & 15; return 8 * (i >> 2) + 4 * n + (i & 3); }
struct Unit { int pm, pn, e, pos0, slot; };

__device__ __forceinline__ v8i cat8(bf16x8 lo, bf16x8 hi) { return __builtin_shufflevector(__builtin_bit_cast(v4i, lo), __builtin_bit_cast(v4i, hi), 0, 1, 2, 3, 4, 5, 6, 7); }
__device__ __forceinline__ unsigned cvt_pk_bf16(float lo, float hi) { return pk2(lo, hi); }

template <class Epi, class Sched, bool F8 = false, bool SP2 = true, bool ALIGN_EPI = true, int KREP = 1, int EPIREP = 1>
__device__ __forceinline__ void gemm_phase(LAS unsigned char* lds, const char* Abase, const int rp, const Sched& S, const Epi& E) {
    const int tid = threadIdx.x, wid = __builtin_amdgcn_readfirstlane(tid >> 6), lane = tid & 63, wr = wid >> 2, wc = wid & 3, fr = lane & 15, fq = lane >> 4;
    const int nt = rp / 128;
    int Rr[2], Cb[2]; unsigned voffB[2];
#pragma unroll
    for (int i = 0; i < 2; ++i) { int R, C; stage_rc(tid * 16 + i * 8192, R, C); Rr[i] = R; Cb[i] = C * 2; const int Rb = Epi::PERM ? ((R & ~31) + perm32(R & 31)) : R; voffB[i] = (unsigned)(Rb * rp + C * 2); }
    const size_t kstep = (size_t)(BK * 2);
    const size_t hstep = (size_t)HALF * rp;
    const unsigned ldsw = (unsigned)wid * 1024u;
    const int aoff = lds_byte(wr * 64 + fr, fq * 8), boff = lds_byte(wc * 32 + fr, fq * 8);
#define PG8_SA(b, h) (((b) * 2 + (h)) * HTB)
#define PG8_SB(b, h) ((4 + (b) * 2 + (h)) * HTB)
#define PG8_STAGE(bufoff, gbase, voff) do { _Pragma("unroll") for (int _i = 0; _i < 2; ++_i) \
        __builtin_amdgcn_global_load_lds((const unsigned*)((const char*)(gbase) + (voff)[_i]), (LAS unsigned*)(lds + (bufoff) + ldsw + _i * 8192), 16, 0, 0); } while (0)
#define PG8_LDA(dst, b, h) do { _Pragma("unroll") for (int m = 0; m < 4; ++m) _Pragma("unroll") for (int k = 0; k < 2; ++k) dst[m][k] = *(const LAS bf16x8*)(lds + PG8_SA(b, h) + aoff + m * 2048 + k * 1024); } while (0)
#define PG8_LDB(dst, b, h) do { _Pragma("unroll") for (int n = 0; n < 2; ++n) _Pragma("unroll") for (int k = 0; k < 2; ++k) dst[n][k] = *(const LAS bf16x8*)(lds + PG8_SB(b, h) + boff + n * 2048 + k * 1024); } while (0)
#define PG8_MMA(ai, bj, At, Bt) do { __builtin_amdgcn_s_setprio(1); _Pragma("unroll") for (int m = 0; m < 4; ++m) _Pragma("unroll") for (int n = 0; n < 2; ++n) { \
        if constexpr (F8) asm volatile("v_mfma_scale_f32_16x16x128_f8f6f4 %0, %1, %2, %0, %3, %4 op_sel_hi:[0,0,0]" : "+v"(acc[ai][bj][m][n]) : "v"(cat8(Bt[n][0], Bt[n][1])), "v"(cat8(At[m][0], At[m][1])), "v"(sc_w), "v"(sc_a)); \
        else { _Pragma("unroll") for (int k = 0; k < 2; ++k) acc[ai][bj][m][n] = __builtin_amdgcn_mfma_f32_16x16x32_bf16(Bt[n][k], At[m][k], acc[ai][bj][m][n], 0, 0, 0); } } \
        __builtin_amdgcn_s_setprio(0); } while (0)
#define PG8_WAIT_V(n) asm volatile("s_waitcnt vmcnt(" #n ")" ::: "memory")
#define PG8_WAIT_L(n) asm volatile("s_waitcnt lgkmcnt(" #n ")" ::: "memory")
#define PG8_BAR __builtin_amdgcn_s_barrier()
#define PG8_SCHED __builtin_amdgcn_sched_barrier(0)
    Unit cur, nxt; int ui = 0;
    if (!S.next(0, cur)) return;
    const int sc_w = Epi::SCALE_W, sc_a = 0x7f7f7f7f;
    f32x4 acc[2][2][4][2];
#pragma unroll
    for (int b = 0; b < 2; ++b)
#pragma unroll
        for (int n = 0; n < 2; ++n) { const f32x4 bi = E.bias(cur, b, n, wc, fq);
#pragma unroll
            for (int a = 0; a < 2; ++a)
#pragma unroll
                for (int m = 0; m < 4; ++m) acc[a][b][m][n] = bi; }
    bf16x8 At[4][2], B0[2][2], B1[2][2];
    unsigned ca[2][2];
    S.a_off(cur, Rr, Cb, ca);
    const char* cB = S.b_ptr(cur);
    if constexpr (SP2) {
        PG8_STAGE(PG8_SB(0, 0), cB, voffB); PG8_STAGE(PG8_SB(0, 1), cB + hstep, voffB); PG8_STAGE(PG8_SA(0, 0), Abase, ca[0]); PG8_STAGE(PG8_SA(0, 1), Abase, ca[1]);
        if (wr == 1) PG8_BAR;
        PG8_WAIT_V(2); PG8_BAR;
        PG8_STAGE(PG8_SB(1, 0), cB + kstep, voffB); PG8_STAGE(PG8_SA(1, 0), Abase + kstep, ca[0]); PG8_STAGE(PG8_SB(1, 1), cB + hstep + kstep, voffB);
        PG8_WAIT_V(6); PG8_BAR;
    } else {
        PG8_STAGE(PG8_SB(0, 0), cB, voffB); PG8_STAGE(PG8_SA(0, 0), Abase, ca[0]); PG8_STAGE(PG8_SB(0, 1), cB + hstep, voffB); PG8_STAGE(PG8_SA(0, 1), Abase, ca[1]);
        if (wr == 1) PG8_BAR;
        PG8_WAIT_V(4); PG8_BAR;
        PG8_STAGE(PG8_SB(1, 0), cB + kstep, voffB); PG8_STAGE(PG8_SA(1, 0), Abase + kstep, ca[0]); PG8_STAGE(PG8_SB(1, 1), cB + hstep + kstep, voffB);
        PG8_WAIT_V(6); PG8_BAR;
    }
    for (;;) {
        const bool has_next = S.next(ui + 1, nxt);
        const char* nB = has_next ? S.b_ptr(nxt) : cB;
        for (int t = 0; t < nt * KREP; t += 2) {
            const bool last = (t == nt * KREP - 2);
            const char* a1 = Abase + (size_t)((t + 1) & (nt - 1)) * kstep;
            const char* a2 = last ? Abase : Abase + (size_t)((t + 2) & (nt - 1)) * kstep; const char* b2 = last ? nB : cB + (size_t)((t + 2) & (nt - 1)) * kstep;
            const char* a3 = a2 + kstep; const char* b3 = b2 + kstep;
            unsigned o2[2][2];
#pragma unroll
            for (int h = 0; h < 2; ++h)
#pragma unroll
                for (int i = 0; i < 2; ++i) o2[h][i] = ca[h][i];
            if (last && has_next) S.a_off(nxt, Rr, Cb, o2);
            if constexpr (SP2) {
            PG8_LDB(B0, 0, 0); PG8_LDB(B1, 0, 1); PG8_SCHED; PG8_LDA(At, 0, 0); PG8_STAGE(PG8_SA(1, 1), a1, ca[1]);
            PG8_WAIT_V(8); PG8_WAIT_L(0); PG8_BAR; PG8_MMA(0, 0, At, B0); PG8_MMA(0, 1, At, B1); PG8_BAR; PG8_SCHED;
            PG8_LDA(At, 0, 1); PG8_STAGE(PG8_SB(0, 0), b2, voffB); PG8_STAGE(PG8_SB(0, 1), b2 + hstep, voffB); PG8_STAGE(PG8_SA(0, 0), a2, o2[0]);
            PG8_WAIT_V(8); PG8_WAIT_L(0); PG8_BAR; PG8_MMA(1, 0, At, B0); PG8_MMA(1, 1, At, B1); PG8_BAR; PG8_SCHED;
            PG8_LDB(B0, 1, 0); PG8_LDB(B1, 1, 1); PG8_SCHED; PG8_LDA(At, 1, 0); PG8_STAGE(PG8_SA(0, 1), a2, o2[1]);
            PG8_WAIT_V(8); PG8_WAIT_L(0); PG8_BAR; PG8_MMA(0, 0, At, B0); PG8_MMA(0, 1, At, B1); PG8_BAR; PG8_SCHED;
            PG8_LDA(At, 1, 1); PG8_STAGE(PG8_SB(1, 0), b3, voffB); PG8_STAGE(PG8_SB(1, 1), b3 + hstep, voffB); PG8_STAGE(PG8_SA(1, 0), a3, o2[0]);
            PG8_WAIT_V(8); PG8_WAIT_L(0); PG8_BAR; PG8_MMA(1, 0, At, B0); PG8_MMA(1, 1, At, B1); PG8_BAR; PG8_SCHED;
            } else {
            PG8_LDB(B0, 0, 0); PG8_SCHED; PG8_LDA(At, 0, 0); PG8_STAGE(PG8_SA(1, 1), a1, ca[1]);
            PG8_WAIT_L(8); PG8_BAR; PG8_WAIT_L(0); PG8_MMA(0, 0, At, B0); PG8_BAR; PG8_SCHED;
            PG8_LDB(B1, 0, 1); PG8_STAGE(PG8_SB(0, 0), b2, voffB);
            PG8_BAR; PG8_WAIT_L(0); PG8_MMA(0, 1, At, B1); PG8_BAR;
            PG8_LDA(At, 0, 1); PG8_STAGE(PG8_SA(0, 0), a2, o2[0]);
            PG8_BAR; PG8_WAIT_L(0); PG8_MMA(1, 0, At, B0); PG8_BAR; PG8_SCHED;
            PG8_STAGE(PG8_SB(0, 1), b2 + hstep, voffB);
            PG8_WAIT_V(6); PG8_BAR; PG8_MMA(1, 1, At, B1); PG8_BAR;
            PG8_LDB(B0, 1, 0); PG8_SCHED; PG8_LDA(At, 1, 0); PG8_STAGE(PG8_SA(0, 1), a2, o2[1]);
            PG8_WAIT_L(8); PG8_BAR; PG8_WAIT_L(0); PG8_MMA(0, 0, At, B0); PG8_BAR; PG8_SCHED;
            PG8_LDB(B1, 1, 1); PG8_STAGE(PG8_SB(1, 0), b3, voffB);
            PG8_BAR; PG8_WAIT_L(0); PG8_MMA(0, 1, At, B1); PG8_BAR;
            PG8_LDA(At, 1, 1); PG8_STAGE(PG8_SA(1, 0), a3, o2[0]);
            PG8_BAR; PG8_WAIT_L(0); PG8_MMA(1, 0, At, B0); PG8_BAR; PG8_SCHED;
            PG8_STAGE(PG8_SB(1, 1), b3 + hstep, voffB);
            PG8_WAIT_V(6); PG8_BAR; PG8_MMA(1, 1, At, B1); PG8_BAR;
            }
        }
        if constexpr (ALIGN_EPI) { if (wr == 0) PG8_BAR; }
        if constexpr (F8) asm volatile("s_nop 15\n\ts_nop 15" ::: "memory");
        if constexpr (KREP > 1) {
#pragma unroll
            for (int a = 0; a < 2; ++a)
#pragma unroll
                for (int b = 0; b < 2; ++b)
#pragma unroll
                    for (int m = 0; m < 4; ++m)
#pragma unroll
                        for (int n = 0; n < 2; ++n) acc[a][b][m][n] *= (1.f / KREP);
        }
#pragma unroll 1
        for (int er = 0; er < EPIREP; ++er) { E(acc, cur, wr, wc, fr, fq); asm volatile("" ::: "memory"); }
        if (!has_next) break;
#pragma unroll
        for (int b = 0; b < 2; ++b)
#pragma unroll
            for (int n = 0; n < 2; ++n) { const f32x4 bi = E.bias(nxt, b, n, wc, fq);
#pragma unroll
                for (int a = 0; a < 2; ++a)
#pragma unroll
                    for (int m = 0; m < 4; ++m) acc[a][b][m][n] = bi; }
        cur = nxt; cB = nB; ++ui;
        if constexpr (ALIGN_EPI) { if (wr == 1) PG8_BAR; }
        S.a_off(cur, Rr, Cb, ca);
    }
    PG8_WAIT_V(0);
    if constexpr (!ALIGN_EPI) { if (wr == 0) PG8_BAR; }
    PG8_BAR;
#undef PG8_SA
#undef PG8_SB
#undef PG8_STAGE
#undef PG8_LDA
#undef PG8_LDB
#undef PG8_MMA
#undef PG8_WAIT_V
#undef PG8_WAIT_L
#undef PG8_BAR
#undef PG8_SCHED
}
}

struct DenseSched {
    static constexpr bool GATHER = false;
    int nM, nN, G, vcu, pitch; const char* Bt;
    __device__ __forceinline__ bool next(int i, pg8::Unit& u) const {
        const int L = i * G + vcu; if (L >= nM * nN) return false;
        const int nig = 8 * nN, gid = L / nig, r = L % nig, fm = gid * 8, gsz = (nM - fm) < 8 ? (nM - fm) : 8;
        u.pm = fm + r % gsz; u.pn = r / gsz; u.e = 0; u.pos0 = 0; u.slot = i; return true;
    }
    __device__ __forceinline__ void a_off(const pg8::Unit& u, const int (&R)[2], const int (&Cb)[2], unsigned (&off)[2][2]) const {
#pragma unroll
        for (int h = 0; h < 2; ++h)
#pragma unroll
            for (int i = 0; i < 2; ++i) off[h][i] = (unsigned)((u.pm * 256 + h * 128 + R[i]) * pitch) + (unsigned)Cb[i];
    }
    __device__ __forceinline__ const char* b_ptr(const pg8::Unit& u) const { return Bt + (size_t)u.pn * 256 * pitch; }
};
template <bool GATHER_> struct MoeSched {
    static constexpr bool GATHER = GATHER_;
    int nN, G, vcu, pitch, ntiles; const LAS int* cnt; const LAS int* tstart; const LAS int* toks; const char* wsb; int which;
    __device__ __forceinline__ bool next(int i, pg8::Unit& u) const {
        const int L = i * G + vcu; if (L >= ntiles * nN) return false;
        const int pm = L / nN; int e = 0;
        for (int j = 1; j < NE; ++j) e += (tstart[j] <= pm) ? 1 : 0;
        u.pm = __builtin_amdgcn_readfirstlane(pm); u.pn = __builtin_amdgcn_readfirstlane(L % nN); u.e = __builtin_amdgcn_readfirstlane(e);
        u.pos0 = __builtin_amdgcn_readfirstlane((pm - tstart[e]) * 256); u.slot = i; return true;
    }
    __device__ __forceinline__ void a_off(const pg8::Unit& u, const int (&R)[2], const int (&Cb)[2], unsigned (&off)[2][2]) const {
#pragma unroll
        for (int h = 0; h < 2; ++h)
#pragma unroll
            for (int i = 0; i < 2; ++i) {
                if (GATHER) off[h][i] = (unsigned)toks[u.slot * 256 + h * 128 + R[i]] * (unsigned)pitch + (unsigned)Cb[i];
                else off[h][i] = (unsigned)((u.pm * 256 + h * 128 + R[i]) * pitch) + (unsigned)Cb[i];
            }
    }
    __device__ __forceinline__ const char* b_ptr(const pg8::Unit& u) const { return wsb + (which == 1 ? w1_off(u.e) : w2_off(u.e)) + (size_t)u.pn * 256 * pitch; }
};
__device__ __forceinline__ void moe_tokens(LAS int* toks, int nN, int G, int vcu, int ntiles, const LAS int* cnt, const LAS int* tstart, const unsigned* list, int tid) {
    for (int i = 0; i < 12; ++i) { const int L = i * G + vcu; if (L >= ntiles * nN) break;
        const int pm = L / nN; int e = 0;
        for (int j = 1; j < NE; ++j) e += (tstart[j] <= pm) ? 1 : 0;
        const int pos = (pm - tstart[e]) * 256 + tid;
        if (tid < 256) toks[i * 256 + tid] = (pos < cnt[e]) ? (int)((list[e * LCAP + pos] & 0xffffu) >> 2) : 0; }
    __syncthreads();
}

constexpr int EPT_OFF = RING_BYTES + 4096 + 12288;
__device__ __forceinline__ void moe_epi_gateup(LAS float* tab, int nN, int G, int vcu, int ntiles, const LAS int* tstart, const float* bg, const float* bu, int tid) {
    for (int i = 0; i < 12; ++i) { const int L = i * G + vcu; if (L >= ntiles * nN) break;
        const int pm = L / nN, pn = L % nN; int e = 0;
        for (int j = 1; j < NE; ++j) e += (tstart[j] <= pm) ? 1 : 0;
        if (tid < 256) { const int j = tid & 127; tab[i * 256 + tid] = (tid < 128) ? bg[e * 1024 + pn * 128 + j] : bu[e * 1024 + pn * 128 + j] + 1.f; } }
    __syncthreads();
}
__device__ __forceinline__ void moe_epi_down(LAS unsigned* tab, int nN, int G, int vcu, int ntiles, const LAS int* cnt, const LAS int* tstart, const unsigned* list, const float* bd, int tid) {
    for (int i = 0; i < 6; ++i) { const int L = i * G + vcu; if (L >= ntiles * nN) break;
        const int pm = L / nN, pn = L % nN; int e = 0;
        for (int j = 1; j < NE; ++j) e += (tstart[j] <= pm) ? 1 : 0;
        const int pos = (pm - tstart[e]) * 256 + tid;
        if (tid < 256) tab[i * 512 + tid] = (pos < cnt[e]) ? list[e * LCAP + pos] : 0xffffffffu;
        else tab[i * 512 + tid] = __builtin_bit_cast(unsigned, bd[e * 1024 + pn * 256 + tid - 256]); }
    __syncthreads();
}
struct EpiProj {
    static constexpr bool PERM = true; static constexpr int SCALE_W = 0x7f7f7f7f;
    bf16* O;
    __device__ __forceinline__ f32x4 bias(const pg8::Unit&, int, int, int, int) const { return (f32x4){0.f, 0.f, 0.f, 0.f}; }
    __device__ __forceinline__ void operator()(const f32x4 (&acc)[2][2][4][2], const pg8::Unit& u, int wr, int wc, int fr, int fq) const {
        const int row0 = u.pm * 256 + wr * 64 + fr, col0 = u.pn * 256 + wc * 32 + 8 * fq;
#pragma unroll
        for (int ai = 0; ai < 2; ++ai)
#pragma unroll
            for (int m = 0; m < 4; ++m) { bf16* rowp = O + (size_t)(row0 + ai * 128 + m * 16) * NIN + col0;
#pragma unroll
                for (int bj = 0; bj < 2; ++bj) { const f32x4 v0 = acc[ai][bj][m][0], v1 = acc[ai][bj][m][1];
                    v4u w; w.x = pg8::cvt_pk_bf16(v0[0], v0[1]); w.y = pg8::cvt_pk_bf16(v0[2], v0[3]); w.z = pg8::cvt_pk_bf16(v1[0], v1[1]); w.w = pg8::cvt_pk_bf16(v1[2], v1[3]);
                    *(v4u*)(rowp + bj * 128) = w; } }
    }
};
struct EpiRes {
    static constexpr bool PERM = false; static constexpr int SCALE_W = 0x7f7f7f7f;
    const float* x; float* out; const float* mod;
    __device__ __forceinline__ f32x4 bias(const pg8::Unit&, int, int, int, int) const { return (f32x4){0.f, 0.f, 0.f, 0.f}; }
    __device__ __forceinline__ void operator()(const f32x4 (&acc)[2][2][4][2], const pg8::Unit& u, int wr, int wc, int fr, int fq) const {
        const int row0 = u.pm * 256 + wr * 64 + fr, col0 = u.pn * 256 + wc * 32 + 4 * fq;
        const int b = (u.pm * 256) / SEQ;
        f32x4 gv[2][2];
#pragma unroll
        for (int bj = 0; bj < 2; ++bj)
#pragma unroll
            for (int n = 0; n < 2; ++n) gv[bj][n] = *(const f32x4*)(mod + b * 6144 + 2048 + col0 + bj * 128 + n * 16);
#pragma unroll
        for (int ai = 0; ai < 2; ++ai)
#pragma unroll
            for (int m = 0; m < 4; ++m) { const size_t off = (size_t)(row0 + ai * 128 + m * 16) * D + col0;
#pragma unroll
                for (int bj = 0; bj < 2; ++bj)
#pragma unroll
                    for (int n = 0; n < 2; ++n) { const f32x4 xv = *(const f32x4*)(x + off + bj * 128 + n * 16); *(f32x4*)(out + off + bj * 128 + n * 16) = xv + gv[bj][n] * acc[ai][bj][m][n]; } }
    }
};
struct EpiGateUp {
    static constexpr bool PERM = true; static constexpr int SCALE_W = 0x7a7a7a7a;
    bf16* act; const LAS float* tab;
    __device__ __forceinline__ f32x4 bias(const pg8::Unit& u, int bj, int n, int wc, int fq) const { return *(const LAS f32x4*)(tab + u.slot * 256 + 128 * bj + wc * 32 + 8 * fq + 4 * n); }
    __device__ __forceinline__ void operator()(const f32x4 (&acc)[2][2][4][2], const pg8::Unit& u, int wr, int wc, int fr, int fq) const {
        const int row0 = u.pm * 256 + wr * 64 + fr, c0 = u.pn * 128 + wc * 32 + 8 * fq;
#pragma unroll
        for (int ai = 0; ai < 2; ++ai)
#pragma unroll
            for (int m = 0; m < 4; ++m) { float o[8];
#pragma unroll
                for (int n = 0; n < 2; ++n) { const f32x4 g4 = acc[ai][0][m][n], u4 = acc[ai][1][m][n];
#pragma unroll
                    for (int jp = 0; jp < 2; ++jp) {
                        f32x2_t g2 = {fminf(g4[2 * jp], 7.f), fminf(g4[2 * jp + 1], 7.f)};
                        const f32x2_t u2 = {__builtin_amdgcn_fmed3f(u4[2 * jp], -6.f, 8.f), __builtin_amdgcn_fmed3f(u4[2 * jp + 1], -6.f, 8.f)};
                        const f32x2_t t2 = g2 * (-1.702f * 1.44269504f);
                        f32x2_t d2 = {__builtin_amdgcn_exp2f(t2.x), __builtin_amdgcn_exp2f(t2.y)}; d2 = d2 + 1.f;
                        const f32x2_t r2 = {__builtin_amdgcn_rcpf(d2.x), __builtin_amdgcn_rcpf(d2.y)};
                        const f32x2_t o2 = (g2 * r2) * u2; o[4 * n + 2 * jp] = o2.x; o[4 * n + 2 * jp + 1] = o2.y; } }
                if (MOE_FP8) *(v2u*)((unsigned char*)act + (size_t)(row0 + ai * 128 + m * 16) * 1024 + c0) = (v2u){pk4_fp8(o[0], o[1], o[2], o[3]), pk4_fp8(o[4], o[5], o[6], o[7])};
                else *(v4u*)(act + (size_t)(row0 + ai * 128 + m * 16) * 1024 + c0) = (v4u){pg8::cvt_pk_bf16(o[0], o[1]), pg8::cvt_pk_bf16(o[2], o[3]), pg8::cvt_pk_bf16(o[4], o[5]), pg8::cvt_pk_bf16(o[6], o[7])}; }
    }
};
struct EpiDown {
    static constexpr bool PERM = true; static constexpr int SCALE_W = 0x7a7a7a7a;
    bf16* slab; const LAS unsigned* tab;
    __device__ __forceinline__ f32x4 bias(const pg8::Unit& u, int bj, int n, int wc, int fq) const { return *(const LAS f32x4*)((const LAS float*)tab + u.slot * 512 + 256 + wc * 32 + 8 * fq + bj * 128 + 4 * n); }
    __device__ __forceinline__ void operator()(const f32x4 (&acc)[2][2][4][2], const pg8::Unit& u, int wr, int wc, int fr, int fq) const {
        const int r0 = wr * 64 + fr, col0 = u.pn * 256 + wc * 32 + 8 * fq;
        unsigned info[2][4];
#pragma unroll
        for (int ai = 0; ai < 2; ++ai)
#pragma unroll
            for (int m = 0; m < 4; ++m) info[ai][m] = tab[u.slot * 512 + r0 + ai * 128 + m * 16];
#pragma unroll
        for (int ai = 0; ai < 2; ++ai)
#pragma unroll
            for (int m = 0; m < 4; ++m) {
                if (info[ai][m] != 0xffffffffu) { const float w = (float)__builtin_bit_cast(_Float16, (unsigned short)(info[ai][m] >> 16)); bf16* rowp = slab + (size_t)(info[ai][m] & 0xffffu) * 1024 + col0;
#pragma unroll
                    for (int bj = 0; bj < 2; ++bj) {
                        if (SLAB_FP8) { const float w32 = w * 32.f; f32x4 v0 = acc[ai][bj][m][0] * w32, v1 = acc[ai][bj][m][1] * w32;
#pragma unroll
                            for (int q = 0; q < 4; ++q) { v0[q] = __builtin_amdgcn_fmed3f(v0[q], -448.f, 448.f); v1[q] = __builtin_amdgcn_fmed3f(v1[q], -448.f, 448.f); }
                            *(v2u*)((unsigned char*)slab + (size_t)(info[ai][m] & 0xffffu) * 1024 + col0 + bj * 128) = (v2u){pk4_fp8(v0[0], v0[1], v0[2], v0[3]), pk4_fp8(v1[0], v1[1], v1[2], v1[3])}; }
                        else { const f32x4 v0 = acc[ai][bj][m][0] * w, v1 = acc[ai][bj][m][1] * w;
                            v4u o; o.x = pg8::cvt_pk_bf16(v0[0], v0[1]); o.y = pg8::cvt_pk_bf16(v0[2], v0[3]); o.z = pg8::cvt_pk_bf16(v1[0], v1[1]); o.w = pg8::cvt_pk_bf16(v1[2], v1[3]);
                            *(v4u*)(rowp + bj * 128) = o; } } } }
    }
};

struct Args { const float* in[26]; float* out; unsigned char* ws; int ph_lo, ph_hi; };
struct Frame { LAS unsigned char* lds; int tid, lane, wave, vcu, G; };

template <class RowMap>
__device__ __forceinline__ void transpose_item(const float* W, int K, int N, bf16* WT, int item, int lane, const RowMap& rm) {
    const int nblk = N / 32, kb = item / nblk, nb = item % nblk, k0 = 64 * kb, n0 = 32 * nb, fr = lane & 15, fq = lane >> 4;
    float v[2][2][8];
#pragma unroll
    for (int kh = 0; kh < 2; ++kh)
#pragma unroll
        for (int j = 0; j < 8; ++j)
#pragma unroll
            for (int nt = 0; nt < 2; ++nt) v[kh][nt][j] = W[(size_t)(k0 + 32 * kh + 8 * fq + j) * N + n0 + 16 * nt + fr];
#pragma unroll
    for (int nt = 0; nt < 2; ++nt) { bf16* orow = WT + (size_t)rm(n0 + 16 * nt + fr) * K + k0 + 8 * fq;
#pragma unroll
        for (int kh = 0; kh < 2; ++kh) *(GAS v4u*)(orow + 32 * kh) = (v4u){pk2(v[kh][nt][0], v[kh][nt][1]), pk2(v[kh][nt][2], v[kh][nt][3]), pk2(v[kh][nt][4], v[kh][nt][5]), pk2(v[kh][nt][6], v[kh][nt][7])}; }
}
template <class RowMap>
__device__ __forceinline__ void transpose_item_f8(const float* W, int K, int N, unsigned char* WT, int item, int lane, const RowMap& rm) {
    const int nblk = N / 32, kb = item / nblk, nb = item % nblk, k0 = 64 * kb, n0 = 32 * nb, fr = lane & 15, fq = lane >> 4;
    float v[2][2][8];
#pragma unroll
    for (int kh = 0; kh < 2; ++kh)
#pragma unroll
        for (int j = 0; j < 8; ++j)
#pragma unroll
            for (int nt = 0; nt < 2; ++nt) v[kh][nt][j] = 32.f * W[(size_t)(k0 + 32 * kh + 8 * fq + j) * N + n0 + 16 * nt + fr];
#pragma unroll
    for (int nt = 0; nt < 2; ++nt) { unsigned char* orow = WT + (size_t)rm(n0 + 16 * nt + fr) * K + k0 + 8 * fq;
#pragma unroll
        for (int kh = 0; kh < 2; ++kh) *(GAS v2u*)(orow + 32 * kh) = (v2u){pk4_fp8(v[kh][nt][0], v[kh][nt][1], v[kh][nt][2], v[kh][nt][3]), pk4_fp8(v[kh][nt][4], v[kh][nt][5], v[kh][nt][6], v[kh][nt][7])}; }
}
struct MapWin { __device__ __forceinline__ int operator()(int n) const { if (n < 2560) return n; if (n < 2576) return PDT + (n - 2560); if (n < 4624) return n - 16; if (n < 4640) return PGL + (n - 4624); return n - 32; } };
struct MapId { __device__ __forceinline__ int operator()(int n) const { return n; } };
struct MapGU { int half; __device__ __forceinline__ int operator()(int c) const { return 256 * (c >> 7) + 128 * half + (c & 127); } };

__device__ __forceinline__ void phase0(const Args& a, Frame& F) {
    const float* c = a.in[1]; const float* w_ada = a.in[2]; const float* b_ada = a.in[3];
    float* mod = (float*)(a.ws + WS_MOD);
    if (F.vcu < 192) {
        LAS float* cond = (LAS float*)(F.lds + 98304);
        LAS float* part = (LAS float*)(F.lds + 98304 + 16384);
        for (int i = F.tid; i < 4096; i += 512) cond[i] = silu_f(c[i]);
        __syncthreads();
        const int col0 = 32 * F.vcu, rsub = F.lane >> 3, c4 = F.lane & 7;
        f32x4 acc[4];
#pragma unroll
        for (int b = 0; b < 4; ++b) acc[b] = (f32x4){0.f, 0.f, 0.f, 0.f};
#pragma unroll 4
        for (int it = 0; it < 16; ++it) { const int k = 128 * F.wave + 8 * it + rsub; const f32x4 wv = *(const f32x4*)(w_ada + (size_t)k * 6144 + col0 + 4 * c4);
#pragma unroll
            for (int b = 0; b < 4; ++b) acc[b] += wv * cond[b * 1024 + k]; }
#pragma unroll
        for (int b = 0; b < 4; ++b)
#pragma unroll
            for (int j = 0; j < 4; ++j) { float v = acc[b][j]; v += __shfl_xor(v, 8); v += __shfl_xor(v, 16); v += __shfl_xor(v, 32); acc[b][j] = v; }
        if (rsub == 0) {
#pragma unroll
            for (int b = 0; b < 4; ++b)
#pragma unroll
                for (int j = 0; j < 4; ++j) part[(F.wave * 4 + b) * 32 + 4 * c4 + j] = acc[b][j]; }
        __syncthreads();
        if (F.tid < 128) { const int b = F.tid >> 5, cc = F.tid & 31; float s = b_ada[col0 + cc];
#pragma unroll
            for (int w = 0; w < 8; ++w) s += part[(w * 4 + b) * 32 + cc];
            mod[b * 6144 + col0 + cc] = s; }
        __syncthreads();
    }
    const int gw = F.vcu * 8 + F.wave, NGW = F.G * 8;
    bf16* WinT = (bf16*)(a.ws + WS_WIN); bf16* WoutT = (bf16*)(a.ws + WS_WOUT);
    constexpr int I_IN = 16 * 177, I_OUT = 32 * 32;
    for (int it = gw; it < I_IN + I_OUT; it += NGW) {
        if (it < I_IN) transpose_item(a.in[5], 1024, 5664, WinT, it, F.lane, MapWin());
        else transpose_item(a.in[15], 2048, 1024, WoutT, it - I_IN, F.lane, MapId());
    }
    for (int i = F.vcu * 512 + F.tid; i < 224 * 1024 / 8; i += F.G * 512) *(v4u*)(WinT + (size_t)5664 * 1024 + (size_t)i * 8) = (v4u){0u, 0u, 0u, 0u};
}
__device__ __forceinline__ void phase1(const Args& a, Frame& F) {
    const float* x = a.in[0]; const float* g1 = a.in[4]; const float* mod = (const float*)(a.ws + WS_MOD); bf16* H = (bf16*)(a.ws + WS_H);
    const int gw = F.vcu * 8 + F.wave, NGW = F.G * 8;
    f32x4 Gm[4], Sh[4], nx[4]; int bprev = -1;
    if (gw < T) {
#pragma unroll
        for (int j = 0; j < 4; ++j) nx[j] = ((const f32x4*)(x + (size_t)gw * D) + F.lane)[64 * j]; }
    for (int m = gw; m < T; m += NGW) {
        const int b = m / SEQ;
        f32x4 v[4]; float s = 0.f;
#pragma unroll
        for (int j = 0; j < 4; ++j) { v[j] = nx[j]; s += (v[j].x * v[j].x + v[j].y * v[j].y) + (v[j].z * v[j].z + v[j].w * v[j].w); }
        if (m + NGW < T) {
#pragma unroll
            for (int j = 0; j < 4; ++j) nx[j] = ((const f32x4*)(x + (size_t)(m + NGW) * D) + F.lane)[64 * j]; }
        if (b != bprev) { bprev = b;
#pragma unroll
            for (int j = 0; j < 4; ++j) { const int d0 = 4 * F.lane + 256 * j; Gm[j] = *(const f32x4*)(g1 + d0) * (*(const f32x4*)(mod + b * 6144 + 1024 + d0) + 1.f); Sh[j] = *(const f32x4*)(mod + b * 6144 + d0); } }
        const float rstd = 1.f / sqrtf(wave_sum(s) * (1.f / D) + EPS);
        v2u* o8 = (v2u*)(H + (size_t)m * D) + F.lane;
#pragma unroll
        for (int j = 0; j < 4; ++j) { const f32x4 h = v[j] * rstd * Gm[j] + Sh[j]; v2u w; w.x = pk2(h.x, h.y); w.y = pk2(h.z, h.w); o8[64 * j] = w; }
    }
}
__device__ __forceinline__ void phase3(const Args& a, Frame& F) {
    const bf16* P = (const bf16*)(a.ws + WS_PROJ); bf16* XA = (bf16*)a.out; float* GK = (float*)(a.ws + WS_GK); float* DT = (float*)(a.ws + WS_DT); bf16* KD = (bf16*)(a.ws + WS_KD); float* DKL = (float*)(a.ws + WS_DKL);
    const float* cw = a.in[6]; const float* cb = a.in[7]; const float* dtb = a.in[8]; const float* wg2 = a.in[12]; const float* bgl = a.in[13];
    const int gt = F.vcu * 512 + F.tid, NT = F.G * 512;
    for (int cidx = F.vcu; cidx < T / 64; cidx += F.G) {
        const int t0 = cidx * 64, k = F.tid; LAS v4u* gl = (LAS v4u*)F.lds;
        LAS float* lrun = (LAS float*)(F.lds + 4096);
        __syncthreads();
        if (F.tid < 128) gl[F.tid] = *(const v4u*)(P + (size_t)(t0 + (F.tid >> 1)) * NIN + PGL + 8 * (F.tid & 1));
        v4u kk8[8];
#pragma unroll
        for (int i = 0; i < 8; ++i) kk8[i] = *(const v4u*)(P + (size_t)(t0 + (F.tid >> 6) + 8 * i) * NIN + PK + 8 * (F.tid & 63));
        float wv[16];
#pragma unroll
        for (int r = 0; r < 16; ++r) wv[r] = wg2[r * 512 + k];
        const float bias = bgl[k]; float run = 0.f;
        __syncthreads();
#pragma unroll 4
        for (int l = 0; l < 64; ++l) {
            const v4u g0 = gl[2 * l], g1 = gl[2 * l + 1]; const unsigned gw[8] = {g0.x, g0.y, g0.z, g0.w, g1.x, g1.y, g1.z, g1.w};
            float s = bias;
#pragma unroll
            for (int r = 0; r < 8; ++r) { s += bflo(gw[r]) * wv[2 * r]; s += bfhi(gw[r]) * wv[2 * r + 1]; }
            run += logsigmoid_f(s) * (1.f / 16.f); GK[(size_t)(t0 + l) * 512 + k] = run; lrun[l * 512 + k] = run; }
        DKL[(size_t)cidx * 512 + k] = __expf(run);
        __syncthreads();
#pragma unroll
        for (int i = 0; i < 8; ++i) { const int l = (F.tid >> 6) + 8 * i, k0 = 8 * (F.tid & 63);
            const v4u kk = kk8[i];
            const f32x4 l0 = *(const LAS f32x4*)(lrun + 63 * 512 + k0), l1 = *(const LAS f32x4*)(lrun + 63 * 512 + k0 + 4), c0 = *(const LAS f32x4*)(lrun + l * 512 + k0), c1 = *(const LAS f32x4*)(lrun + l * 512 + k0 + 4);
            const float bl[8] = {l0.x, l0.y, l0.z, l0.w, l1.x, l1.y, l1.z, l1.w}, bc[8] = {c0.x, c0.y, c0.z, c0.w, c1.x, c1.y, c1.z, c1.w}; const unsigned kw[4] = {kk.x, kk.y, kk.z, kk.w}; unsigned ko[4];
#pragma unroll
            for (int j = 0; j < 4; ++j) ko[j] = pk2(bflo(kw[j]) * __expf(bl[2 * j] - bc[2 * j]), bfhi(kw[j]) * __expf(bl[2 * j + 1] - bc[2 * j + 1]));
            *(v4u*)(KD + (size_t)(t0 + l) * 512 + k0) = (v4u){ko[0], ko[1], ko[2], ko[3]}; }
    }
    { float* SW = (float*)(a.ws + WS_SW); float* SCD = (float*)(a.ws + WS_SCD); const float* a_log = a.in[9];
      for (int u = F.vcu * 8 + F.wave; u < NB * 32 * 16; u += F.G * 8) { const int h = u & 15, bc = u >> 4, t0 = bc * 128, i = F.lane;
        const float av = -__expf(a_log[h]);
        const float d0 = softplus_f(bf2f(P[(size_t)(t0 + 2 * i) * NIN + PDT + h]) + dtb[h]), d1 = softplus_f(bf2f(P[(size_t)(t0 + 2 * i + 1) * NIN + PDT + h]) + dtb[h]);
        DT[(size_t)(t0 + 2 * i) * 16 + h] = d0; DT[(size_t)(t0 + 2 * i + 1) * 16 + h] = d1;
        const float a0 = d0 * av, a1 = d1 * av; float s = a0 + a1;
#pragma unroll
        for (int o = 1; o < 64; o <<= 1) { const float t = __shfl_up(s, o); if (i >= o) s += t; }
        const float cend = __shfl(s, 63);
        SW[(size_t)(t0 + 2 * i) * 16 + h] = d0 * __expf(cend - (s - a1)); SW[(size_t)(t0 + 2 * i + 1) * 16 + h] = d1 * __expf(cend - s);
        if (i == 63) SCD[u] = __expf(cend); } }
    { const int cq = gt % 192, tb0 = gt / 192, c0 = cq * 8; const int TBS = NT / 192; constexpr int NTB = T / 8;
      if (tb0 < TBS) {
        f32x4 wl[4][2];
#pragma unroll
        for (int r = 0; r < 4; ++r) { wl[r][0] = *(const f32x4*)(cw + r * 1536 + c0); wl[r][1] = *(const f32x4*)(cw + r * 1536 + c0 + 4); }
        const f32x4 b0 = *(const f32x4*)(cb + c0), b1 = *(const f32x4*)(cb + c0 + 4);
        v4u rows[11], nrows[11];
        auto ld_rows = [&](int tb, v4u (&rw)[11]) { const int t0 = tb * 8; const bool first = (t0 % SEQ) == 0;
#pragma unroll
            for (int rr = 0; rr < 11; ++rr) { if (rr < 3 && first) rw[rr] = (v4u){0u, 0u, 0u, 0u}; else rw[rr] = *(const v4u*)(P + (size_t)(t0 - 3 + rr) * NIN + PX + c0); } };
        ld_rows(tb0, rows);
        for (int tb = tb0; tb < NTB; tb += TBS) { const int t0 = tb * 8;
            if (tb + TBS < NTB) ld_rows(tb + TBS, nrows);
#pragma unroll
            for (int tt = 0; tt < 8; ++tt) { f32x4 o0 = b0, o1 = b1;
#pragma unroll
                for (int r = 0; r < 4; ++r) { const v4u pv = rows[tt + r];
                    o0 += wl[r][0] * (f32x4){bflo(pv.x), bfhi(pv.x), bflo(pv.y), bfhi(pv.y)}; o1 += wl[r][1] * (f32x4){bflo(pv.z), bfhi(pv.z), bflo(pv.w), bfhi(pv.w)}; }
                *(v4u*)(XA + (size_t)(t0 + tt) * 1536 + c0) = (v4u){pk2(silu_f(o0.x), silu_f(o0.y)), pk2(silu_f(o0.z), silu_f(o0.w)), pk2(silu_f(o1.x), silu_f(o1.y)), pk2(silu_f(o1.z), silu_f(o1.w))}; }
#pragma unroll
            for (int rr = 0; rr < 11; ++rr) rows[rr] = nrows[rr];
        } } }
}
typedef LAS unsigned char* ldsp;
#define MFMA16(a, b, c) __builtin_amdgcn_mfma_f32_16x16x32_bf16(a, b, c, 0, 0, 0)
__device__ __forceinline__ bf16x8 ldfrag(ldsp base, int row, int stride, int kel) { return *(const LAS bf16x8*)(base + row * stride + kel * 2); }
constexpr float QSCALE = 0.08838834764831845f;

__device__ __forceinline__ void ssd_dtcs(const Args& a, Frame& F, int b, int c, int g, LAS float* dtv, LAS float* csv, float* cd_out) {
    const float* DT = (const float*)(a.ws + WS_DT); const int t0 = b * SEQ + c * 128, hh = F.wave, h = g * 8 + hh, i = F.lane;
    const float av = -__expf(a.in[9][h]);
    const float d0 = DT[(size_t)(t0 + 2 * i) * 16 + h], d1 = DT[(size_t)(t0 + 2 * i + 1) * 16 + h];
    const float a0 = d0 * av, a1 = d1 * av; float s = a0 + a1;
#pragma unroll
    for (int o = 1; o < 64; o <<= 1) { const float t = __shfl_up(s, o); if (i >= o) s += t; }
    dtv[hh * 128 + 2 * i] = d0; dtv[hh * 128 + 2 * i + 1] = d1; csv[hh * 128 + 2 * i] = s - a1; csv[hh * 128 + 2 * i + 1] = s;
    if (cd_out != nullptr && i == 63) cd_out[(b * 32 + c) * 16 + h] = __expf(s);
}
__device__ __forceinline__ void p4a_ssd(const Args& a, Frame& F, int item) {
    const int b = item >> 6, c = (item >> 1) & 31, g = item & 1, t0 = b * SEQ + c * 128;
    const bf16* XA = (const bf16*)a.out; bf16* SS = (bf16*)(a.ws + WS_SS);
    ldsp BT = F.lds, xwT = F.lds + 34816; LAS float* dtv = (LAS float*)(F.lds + 52224); LAS float* csv = dtv + 1024;
    const int w = F.wave, fr = F.lane & 15, fq = F.lane >> 4;
    ssd_dtcs(a, F, b, c, g, dtv, csv, (float*)(a.ws + WS_CD));
#pragma unroll
    for (int q = 0; q < 4; ++q) { const int idx = F.tid + 512 * q, n = idx & 127, lc = idx >> 7; const bf16* xb = XA + (size_t)t0 * 1536; const unsigned off = (unsigned)(8 * lc * 1536 + 1024 + g * 128 + n);
        unsigned e[8];
#pragma unroll
        for (int j = 0; j < 8; ++j) e[j] = (xb + j * 1536)[off];
        *(LAS v4u*)(BT + n * 272 + lc * 16) = (v4u){e[0] | (e[1] << 16), e[2] | (e[3] << 16), e[4] | (e[5] << 16), e[6] | (e[7] << 16)}; }
    __syncthreads();
    bf16x8 Bf[4];
#pragma unroll
    for (int ks = 0; ks < 4; ++ks) Bf[ks] = ldfrag(BT, 16 * w + fr, 272, 32 * ks + 8 * fq);
    for (int hh = 0; hh < 8; ++hh) {
        const int h = g * 8 + hh; const float cend = csv[hh * 128 + 127];
#pragma unroll
        for (int q = 0; q < 2; ++q) { const int idx = F.tid + 512 * q, p = idx & 63, lc = idx >> 6; const bf16* xb = XA + (size_t)t0 * 1536 + g * 512 + hh * 64; const unsigned off = (unsigned)(8 * lc * 1536 + p);
            float f[8];
#pragma unroll
            for (int j = 0; j < 8; ++j) { const int l = 8 * lc + j; f[j] = bf2f((xb + j * 1536)[off]) * dtv[hh * 128 + l] * __expf(cend - csv[hh * 128 + l]); }
            *(LAS v4u*)(xwT + p * 272 + lc * 16) = (v4u){pk2(f[0], f[1]), pk2(f[2], f[3]), pk2(f[4], f[5]), pk2(f[6], f[7])}; }
        __syncthreads();
        f32x4 acc[4];
#pragma unroll
        for (int tp = 0; tp < 4; ++tp) acc[tp] = (f32x4){0.f, 0.f, 0.f, 0.f};
#pragma unroll
        for (int ks = 0; ks < 4; ++ks)
#pragma unroll
            for (int tp = 0; tp < 4; ++tp) acc[tp] = MFMA16(Bf[ks], ldfrag(xwT, 16 * tp + fr, 272, 32 * ks + 8 * fq), acc[tp]);
#pragma unroll
        for (int tp = 0; tp < 4; ++tp) *(v2u*)(SS + ((size_t)((b * 32 + c) * 16 + h) * 64 + 16 * tp + fr) * 128 + 16 * w + 4 * fq) = (v2u){pk2(acc[tp][0], acc[tp][1]), pk2(acc[tp][2], acc[tp][3])};
        __syncthreads();
    }
}
__device__ __forceinline__ void p4a_gla(const Args& a, Frame& F, int item) {
    const int b = item >> 8, c = (item >> 2) & 63, h = item & 3, t0 = b * SEQ + c * 64;
    const bf16* P = (const bf16*)(a.ws + WS_PROJ); const float* BC = (const float*)(a.ws + WS_GK); bf16* GS = (bf16*)(a.ws + WS_GS); float* GD = (float*)(a.ws + WS_GD);
    ldsp kdT = F.lds, vT = F.lds + 18432;
    const int w = F.wave, fr = F.lane & 15, fq = F.lane >> 4;
#pragma unroll
    for (int q = 0; q < 2; ++q) { const int idx = F.tid + 512 * q, k = idx & 127, lc = idx >> 7;
        const float bl = BC[(size_t)(t0 + 63) * 512 + h * 128 + k]; float f[8];
#pragma unroll
        for (int j = 0; j < 8; ++j) { const int l = 8 * lc + j; f[j] = bf2f(P[(size_t)(t0 + l) * NIN + PK + h * 128 + k]) * __expf(bl - BC[(size_t)(t0 + l) * 512 + h * 128 + k]); }
        *(LAS v4u*)(kdT + k * 144 + lc * 16) = (v4u){pk2(f[0], f[1]), pk2(f[2], f[3]), pk2(f[4], f[5]), pk2(f[6], f[7])};
        if (lc == 0) GD[((b * 64 + c) * 4 + h) * 128 + k] = __expf(bl); }
#pragma unroll
    for (int q = 0; q < 4; ++q) { const int idx = F.tid + 512 * q, v = idx & 255, lc = idx >> 8; const bf16* pb = P + (size_t)t0 * NIN + PV + h * 256; const unsigned off = (unsigned)(8 * lc * NIN + v);
        unsigned e[8];
#pragma unroll
        for (int j = 0; j < 8; ++j) e[j] = (pb + j * NIN)[off];
        *(LAS v4u*)(vT + v * 144 + lc * 16) = (v4u){e[0] | (e[1] << 16), e[2] | (e[3] << 16), e[4] | (e[5] << 16), e[6] | (e[7] << 16)}; }
    __syncthreads();
    bf16x8 Kf[2];
#pragma unroll
    for (int ks = 0; ks < 2; ++ks) Kf[ks] = ldfrag(kdT, 16 * w + fr, 144, 32 * ks + 8 * fq);
#pragma unroll
    for (int tg = 0; tg < 4; ++tg) { f32x4 acc[4];
#pragma unroll
        for (int i = 0; i < 4; ++i) acc[i] = (f32x4){0.f, 0.f, 0.f, 0.f};
#pragma unroll
        for (int ks = 0; ks < 2; ++ks)
#pragma unroll
            for (int i = 0; i < 4; ++i) acc[i] = MFMA16(Kf[ks], ldfrag(vT, 16 * (4 * tg + i) + fr, 144, 32 * ks + 8 * fq), acc[i]);
#pragma unroll
        for (int i = 0; i < 4; ++i) *(v2u*)(GS + ((size_t)((b * 64 + c) * 4 + h) * 256 + 16 * (4 * tg + i) + fr) * 128 + 16 * w + 4 * fq) = (v2u){pk2(acc[i][0], acc[i][1]), pk2(acc[i][2], acc[i][3])}; }
    __syncthreads();
}
__device__ __forceinline__ void p4b_scan(const Args& a, Frame& F) {
    bf16* SS = (bf16*)(a.ws + WS_SS); bf16* GS = (bf16*)(a.ws + WS_GS); const float* CD = (const float*)(a.ws + WS_CD); const float* GD = (const float*)(a.ws + WS_GD);
    for (int gid = F.vcu * 512 + F.tid; gid < 131072; gid += F.G * 512) {
        { const int b = gid >> 15, rem = gid & 32767, h = rem >> 11, r2 = rem & 2047; float run[4] = {0.f, 0.f, 0.f, 0.f};
          for (int c0 = 0; c0 < 32; c0 += 16) { v2u ld[16]; float dec[16];
#pragma unroll
            for (int u = 0; u < 16; ++u) { ld[u] = *(const v2u*)(SS + (size_t)((b * 32 + c0 + u) * 16 + h) * 8192 + r2 * 4); dec[u] = CD[(b * 32 + c0 + u) * 16 + h]; }
#pragma unroll
            for (int u = 0; u < 16; ++u) { *(v2u*)(SS + (size_t)((b * 32 + c0 + u) * 16 + h) * 8192 + r2 * 4) = (v2u){pk2(run[0], run[1]), pk2(run[2], run[3])};
                run[0] = run[0] * dec[u] + bflo(ld[u].x); run[1] = run[1] * dec[u] + bfhi(ld[u].x); run[2] = run[2] * dec[u] + bflo(ld[u].y); run[3] = run[3] * dec[u] + bfhi(ld[u].y); } } }
        { const int b = gid >> 15, rem = gid & 32767, h = rem >> 13, r2 = rem & 8191, k4 = r2 & 31; float run[4] = {0.f, 0.f, 0.f, 0.f};
          for (int c0 = 0; c0 < 64; c0 += 16) { v2u ld[16]; f32x4 dec[16];
#pragma unroll
            for (int u = 0; u < 16; ++u) { ld[u] = *(const v2u*)(GS + (size_t)((b * 64 + c0 + u) * 4 + h) * 32768 + r2 * 4); dec[u] = *(const f32x4*)(GD + ((b * 64 + c0 + u) * 4 + h) * 128 + 4 * k4); }
#pragma unroll
            for (int u = 0; u < 16; ++u) { *(v2u*)(GS + (size_t)((b * 64 + c0 + u) * 4 + h) * 32768 + r2 * 4) = (v2u){pk2(run[0], run[1]), pk2(run[2], run[3])};
                run[0] = run[0] * dec[u].x + bflo(ld[u].x); run[1] = run[1] * dec[u].y + bfhi(ld[u].x); run[2] = run[2] * dec[u].z + bflo(ld[u].y); run[3] = run[3] * dec[u].w + bfhi(ld[u].y); } } }
    }
}
#define LDS_SYNC() asm volatile("s_waitcnt lgkmcnt(0)\n\ts_barrier" ::: "memory")
__device__ __forceinline__ int swz128(int row) { return (((row >> 1) & 1) | (((row >> 3) & 1) << 1)) << 1; }
typedef short v4s_ __attribute__((ext_vector_type(4)));
__device__ __forceinline__ bf16x8 ldfrag_tr128(ldsp tile, int kbase, int c0, int lane) {
    const int g = lane >> 4, q = (lane >> 2) & 3, p = lane & 3, col = (c0 + 4 * p) * 2;
    ldsp ad = tile + (kbase + 8 * g + q) * 128 + ((((col >> 4) ^ (((q >> 1) | ((g & 1) << 1)) << 1)) << 4) | (col & 15));
    const v4s_ lo = __builtin_amdgcn_ds_read_tr16_b64_v4i16((LAS v4s_*)ad), hi = __builtin_amdgcn_ds_read_tr16_b64_v4i16((LAS v4s_*)(ad + 4 * 128));
    return __builtin_shufflevector(lo, hi, 0, 1, 2, 3, 4, 5, 6, 7);
}
__device__ __forceinline__ int swz256(int row) { return ((row & 3) | (((row >> 3) & 1) << 2)) << 1; }
__device__ __forceinline__ bf16x8 ldfrag_tr512(ldsp tile, int kbase, int c0, int lane) {
    const int g = lane >> 4, q = (lane >> 2) & 3, p = lane & 3, col = (c0 + 4 * p) * 2;
    ldsp ad = tile + (kbase + 8 * g + q) * 512 + ((((col >> 4) ^ ((q | ((g & 1) << 2)) << 1)) << 4) | (col & 15));
    const v4s_ lo = __builtin_amdgcn_ds_read_tr16_b64_v4i16((LAS v4s_*)ad), hi = __builtin_amdgcn_ds_read_tr16_b64_v4i16((LAS v4s_*)(ad + 4 * 512));
    return __builtin_shufflevector(lo, hi, 0, 1, 2, 3, 4, 5, 6, 7);
}
__device__ __forceinline__ void p4c_ssd(const Args& a, Frame& F, int item) {
    const int b = item >> 6, c = (item >> 1) & 31, g = item & 1, t0 = b * SEQ + c * 128;
    const bf16* P = (const bf16*)(a.ws + WS_PROJ); const bf16* XA = (const bf16*)a.out; const bf16* SS = (const bf16*)(a.ws + WS_SS); bf16* MX = (bf16*)(a.ws + WS_MIX);
    const float* dsk = a.in[10]; const float* sng = a.in[11];
    ldsp Cs = F.lds, Ms0 = F.lds + 34816; LAS float* dtv = (LAS float*)(F.lds + 104448); LAS float* csv = dtv + 1024;
    const int w = (F.wave < 4) ? F.wave : 11 - F.wave, fr = F.lane & 15, fq = F.lane >> 4, l = 16 * w + fr;
    v4u xr[2], pr[2]; v2u zr[4];
    auto ld_head = [&](int hn) {
#pragma unroll
        for (int q = 0; q < 2; ++q) { const int idx = F.tid + 512 * q; xr[q] = *(const v4u*)(XA + (size_t)(t0 + (idx >> 3)) * 1536 + g * 512 + hn * 64 + 8 * (idx & 7)); }
#pragma unroll
        for (int q = 0; q < 2; ++q) { const int idx = F.tid + 512 * q; pr[q] = *(const v4u*)(SS + ((size_t)((b * 32 + c) * 16 + g * 8 + hn) * 64 + (idx >> 4)) * 128 + 8 * (idx & 15)); }
#pragma unroll
        for (int tp = 0; tp < 4; ++tp) zr[tp] = *(const v2u*)(P + (size_t)(t0 + l) * NIN + PZ + g * 512 + hn * 64 + 16 * tp + 4 * fq);
    };
    ld_head(0);
    ssd_dtcs(a, F, b, c, g, dtv, csv, nullptr);
    LAS float* dskl = (LAS float*)(F.lds + 147456);
    LAS float* gaml = (LAS float*)(F.lds + 147520);
    if (F.tid < 8) dskl[F.tid] = dsk[g * 8 + F.tid];
    if (F.tid < 128) *(LAS f32x4*)(gaml + 4 * F.tid) = *(const f32x4*)(sng + g * 512 + 4 * F.tid);
#pragma unroll
    for (int q = 0; q < 4; ++q) { const int idx = F.tid + 512 * q, ll = idx >> 4, ch = idx & 15;
        *(LAS v4u*)(Cs + ll * 272 + ch * 16) = *(const v4u*)(XA + (size_t)(t0 + ll) * 1536 + 1280 + g * 128 + 8 * ch);
        *(LAS v4u*)(Ms0 + ll * 272 + ch * 16) = *(const v4u*)(XA + (size_t)(t0 + ll) * 1536 + 1024 + g * 128 + 8 * ch); }
    __syncthreads();
    bf16x8 Cf[4];
#pragma unroll
    for (int ks = 0; ks < 4; ++ks) Cf[ks] = ldfrag(Cs, l, 272, 32 * ks + 8 * fq);
    f32x4 cb[8];
#pragma unroll
    for (int ts = 0; ts < 8; ++ts) { cb[ts] = (f32x4){0.f, 0.f, 0.f, 0.f};
        if (ts <= w) {
#pragma unroll
            for (int ks = 0; ks < 4; ++ks) cb[ts] = MFMA16(ldfrag(Ms0, 16 * ts + fr, 272, 32 * ks + 8 * fq), Cf[ks], cb[ts]); } }
    __syncthreads();
    float ssq = 0.f;
#pragma unroll 1
    for (int hh = 0; hh < 8; ++hh) {
        const bool odd = (hh & 1) != 0; ldsp Ms = odd ? F.lds : F.lds + 34816; ldsp xs = odd ? F.lds + 112640 : F.lds + 69632; ldsp prevs = odd ? F.lds + 130048 : F.lds + 87040;
#pragma unroll
        for (int q = 0; q < 2; ++q) { const int idx = F.tid + 512 * q, row = idx >> 3, ch = idx & 7; *(LAS v4u*)(xs + row * 128 + ((ch ^ swz128(row)) << 4)) = xr[q]; }
#pragma unroll
        for (int q = 0; q < 2; ++q) { const int idx = F.tid + 512 * q, p = idx >> 4, ch = idx & 15; *(LAS v4u*)(prevs + p * 272 + ch * 16) = pr[q]; }
        v2u zc[4];
#pragma unroll
        for (int tp = 0; tp < 4; ++tp) zc[tp] = zr[tp];
        const float csl = csv[hh * 128 + l];
#pragma unroll
        for (int ts = 0; ts < 8; ++ts) { float m[4] = {0.f, 0.f, 0.f, 0.f};
            if (ts <= w) { const f32x4 c4 = *(const LAS f32x4*)(csv + hh * 128 + 16 * ts + 4 * fq), d4 = *(const LAS f32x4*)(dtv + hh * 128 + 16 * ts + 4 * fq);
#pragma unroll
                for (int j = 0; j < 4; ++j) { const int s = 16 * ts + 4 * fq + j; const float v = cb[ts][j] * __expf(fminf(csl - c4[j], 0.f)) * d4[j]; m[j] = (s <= l) ? v : 0.f; } }
            *(LAS v2u*)(Ms + l * 272 + (16 * ts + 4 * fq) * 2) = (v2u){pk2(m[0], m[1]), pk2(m[2], m[3])}; }
        LDS_SYNC();
        if (hh + 1 < 8) ld_head(hh + 1);
        f32x4 y1[4], y2[4];
#pragma unroll
        for (int tp = 0; tp < 4; ++tp) { y1[tp] = (f32x4){0.f, 0.f, 0.f, 0.f}; y2[tp] = (f32x4){0.f, 0.f, 0.f, 0.f}; }
        const int ksmax = (16 * w + 15) >> 5;
        for (int ks = 0; ks <= ksmax; ++ks) { const bf16x8 Mf = ldfrag(Ms, l, 272, 32 * ks + 8 * fq);
#pragma unroll
            for (int tp = 0; tp < 4; ++tp) y1[tp] = MFMA16(ldfrag_tr128(xs, 32 * ks, 16 * tp, F.lane), Mf, y1[tp]); }
#pragma unroll
        for (int ks = 0; ks < 4; ++ks)
#pragma unroll
            for (int tp = 0; tp < 4; ++tp) y2[tp] = MFMA16(ldfrag(prevs, 16 * tp + fr, 272, 32 * ks + 8 * fq), Cf[ks], y2[tp]);
        const float el = __expf(csl), dk = dskl[hh];
#pragma unroll
        for (int tp = 0; tp < 4; ++tp) { const int p0 = 16 * tp + 4 * fq; const v2u zz = zc[tp];
            const float zf[4] = {bflo(zz.x), bfhi(zz.x), bflo(zz.y), bfhi(zz.y)}; float u[4];
            const v2u x4 = *(const LAS v2u*)(xs + l * 128 + ((((p0 * 2) >> 4) ^ swz128(l)) << 4) + ((p0 * 2) & 15)); const float xf[4] = {bflo(x4.x), bfhi(x4.x), bflo(x4.y), bfhi(x4.y)};
#pragma unroll
            for (int j = 0; j < 4; ++j) { const float y = y1[tp][j] + y2[tp][j] * el + dk * xf[j]; u[j] = y * silu_f(zf[j]); ssq += u[j] * u[j]; }
            *(v2u*)(MX + (size_t)(t0 + l) * 2048 + g * 512 + hh * 64 + p0) = (v2u){pk2(u[0], u[1]), pk2(u[2], u[3])}; }
    }
    __syncthreads();
    ssq += __shfl_xor(ssq, 16); ssq += __shfl_xor(ssq, 32);
    const float rstd = 1.f / sqrtf(ssq * (1.f / 512.f) + EPS);
    LAS float* rsl = (LAS float*)(F.lds + 149568);
    if (fq == 0) rsl[l] = rstd;
    VM_WAIT();
    __syncthreads();
#pragma unroll 1
    for (int hb = 0; hb < 2; ++hb) {
        v4u wv[8];
#pragma unroll
        for (int i = 0; i < 8; ++i) { const int id = (8 * hb + i) * 512 + F.tid; wv[i] = *(const v4u*)(MX + (size_t)(t0 + (id >> 6)) * 2048 + g * 512 + 8 * (id & 63)); }
        asm volatile("" ::: "memory");
#pragma unroll
        for (int i = 0; i < 8; ++i) { const int id = (8 * hb + i) * 512 + F.tid, row = id >> 6, c8 = 8 * (id & 63); const float r = rsl[row];
            const f32x4 g0 = *(const LAS f32x4*)(gaml + c8), g1 = *(const LAS f32x4*)(gaml + c8 + 4);
            *(v4u*)(MX + (size_t)(t0 + row) * 2048 + g * 512 + c8) = (v4u){pk2(bflo(wv[i].x) * r * g0.x, bfhi(wv[i].x) * r * g0.y), pk2(bflo(wv[i].y) * r * g0.z, bfhi(wv[i].y) * r * g0.w),
                                                                          pk2(bflo(wv[i].z) * r * g1.x, bfhi(wv[i].z) * r * g1.y), pk2(bflo(wv[i].w) * r * g1.z, bfhi(wv[i].w) * r * g1.w)}; }
    }
    __syncthreads();
}
struct GlaStage { v4u q8[2], k8[2]; f32x4 b0[2], b1[2]; };
__device__ __forceinline__ void gla_stage_load(GlaStage& S, const Args& a, Frame& F, int item) {
    const int b = item >> 8, c = (item >> 2) & 63, h = item & 3, t0 = b * SEQ + c * 64;
    const bf16* P = (const bf16*)(a.ws + WS_PROJ); const float* BC = (const float*)(a.ws + WS_GK);
#pragma unroll
    for (int q = 0; q < 2; ++q) { const int idx = F.tid + 512 * q, l = idx >> 4, ch = idx & 15;
        S.q8[q] = *(const v4u*)(P + (size_t)(t0 + l) * NIN + PQ + h * 128 + 8 * ch); S.k8[q] = *(const v4u*)(P + (size_t)(t0 + l) * NIN + PK + h * 128 + 8 * ch);
        const f32x4* bp = (const f32x4*)(BC + (size_t)(t0 + l) * 512 + h * 128 + 8 * ch); S.b0[q] = bp[0]; S.b1[q] = bp[1]; }
}
__device__ __forceinline__ void p4c_gla(const Args& a, Frame& F, int item, GlaStage& S, int next_item) {
    const int b = item >> 8, c = (item >> 2) & 63, h = item & 3, t0 = b * SEQ + c * 64;
    const bf16* P = (const bf16*)(a.ws + WS_PROJ); const float* BC = (const float*)(a.ws + WS_GK); const bf16* GS = (const bf16*)(a.ws + WS_GS); bf16* MX = (bf16*)(a.ws + WS_MIX); const float* gng = a.in[14];
    ldsp qt = F.lds, kt = F.lds + 17408, att = F.lds + 34816, vT = F.lds + 44032; LAS float* part = (LAS float*)(F.lds + 80896);
    const int w = F.wave, fr = F.lane & 15, fq = F.lane >> 4;
    bf16x8 PF[2][4]; v2u rrv[4][2]; v4u vv[4];
#pragma unroll
    for (int q = 0; q < 4; ++q) { const int idx = F.tid + 512 * q, row = idx >> 5, ch = idx & 31; vv[q] = *(const v4u*)(P + (size_t)(t0 + row) * NIN + PV + h * 256 + 8 * ch); }
#pragma unroll
    for (int tl = 0; tl < 4; ++tl)
#pragma unroll
        for (int tvi = 0; tvi < 2; ++tvi) rrv[tl][tvi] = *(const v2u*)(P + (size_t)(t0 + 16 * tl + fr) * NIN + PR + h * 256 + 16 * (2 * w + tvi) + 4 * fq);
#pragma unroll
    for (int q = 0; q < 2; ++q) { const int idx = F.tid + 512 * q, l = idx >> 4, ch = idx & 15;
        const v4u q8 = S.q8[q], k8 = S.k8[q]; const f32x4 b0 = S.b0[q], b1 = S.b1[q];
        const float bc[8] = {b0.x, b0.y, b0.z, b0.w, b1.x, b1.y, b1.z, b1.w}; const unsigned qw[4] = {q8.x, q8.y, q8.z, q8.w}, kw[4] = {k8.x, k8.y, k8.z, k8.w}; unsigned qo[4], ko[4];
#pragma unroll
        for (int j = 0; j < 4; ++j) { const float e0 = __expf(bc[2 * j]), e1 = __expf(bc[2 * j + 1]), i0 = __expf(-bc[2 * j]), i1 = __expf(-bc[2 * j + 1]);
            qo[j] = pk2(bflo(qw[j]) * e0 * QSCALE, bfhi(qw[j]) * e1 * QSCALE); ko[j] = pk2(bflo(kw[j]) * i0, bfhi(kw[j]) * i1); }
        *(LAS v4u*)(qt + l * 272 + ch * 16) = (v4u){qo[0], qo[1], qo[2], qo[3]}; *(LAS v4u*)(kt + l * 272 + ch * 16) = (v4u){ko[0], ko[1], ko[2], ko[3]}; }
    asm volatile("" ::: "memory");
    LDS_SYNC();
    if (next_item >= 0) gla_stage_load(S, a, F, next_item);
#pragma unroll
    for (int tvi = 0; tvi < 2; ++tvi)
#pragma unroll
        for (int ks = 0; ks < 4; ++ks) PF[tvi][ks] = *(const bf16x8*)(GS + ((size_t)((b * 64 + c) * 4 + h) * 256 + 16 * (2 * w + tvi) + fr) * 128 + 32 * ks + 8 * fq);
#pragma unroll
    for (int ti = 0; ti < 2; ++ti) { const int id = 2 * w + ti, tl = id >> 2, ts = id & 3; f32x4 acc = (f32x4){0.f, 0.f, 0.f, 0.f};
        if (ts <= tl) {
#pragma unroll
            for (int ks = 0; ks < 4; ++ks) acc = MFMA16(ldfrag(kt, 16 * ts + fr, 272, 32 * ks + 8 * fq), ldfrag(qt, 16 * tl + fr, 272, 32 * ks + 8 * fq), acc); }
        const int l = 16 * tl + fr; float m[4];
#pragma unroll
        for (int j = 0; j < 4; ++j) { const int s = 16 * ts + 4 * fq + j; m[j] = (s <= l) ? acc[j] : 0.f; }
        *(LAS v2u*)(att + l * 144 + (16 * ts + 4 * fq) * 2) = (v2u){pk2(m[0], m[1]), pk2(m[2], m[3])}; }
#pragma unroll
    for (int q = 0; q < 4; ++q) { const int idx = F.tid + 512 * q, row = idx >> 5, ch = idx & 31; *(LAS v4u*)(vT + row * 512 + ((ch ^ swz256(row)) << 4)) = vv[q]; }
    LDS_SYNC();
    f32x4 o[4][2];
#pragma unroll
    for (int tl = 0; tl < 4; ++tl) {
        bf16x8 af[2], qf[4];
#pragma unroll
        for (int ks = 0; ks < 2; ++ks) af[ks] = ldfrag(att, 16 * tl + fr, 144, 32 * ks + 8 * fq);
#pragma unroll
        for (int ks = 0; ks < 4; ++ks) qf[ks] = ldfrag(qt, 16 * tl + fr, 272, 32 * ks + 8 * fq);
        f32x4 a0 = (f32x4){0.f, 0.f, 0.f, 0.f}, a1 = (f32x4){0.f, 0.f, 0.f, 0.f};
#pragma unroll
        for (int ks = 0; ks < 2; ++ks) { a0 = MFMA16(ldfrag_tr512(vT, 32 * ks, 16 * (2 * w), F.lane), af[ks], a0); a1 = MFMA16(ldfrag_tr512(vT, 32 * ks, 16 * (2 * w + 1), F.lane), af[ks], a1); }
#pragma unroll
        for (int ks = 0; ks < 4; ++ks) { a0 = MFMA16(PF[0][ks], qf[ks], a0); a1 = MFMA16(PF[1][ks], qf[ks], a1); }
        o[tl][0] = a0; o[tl][1] = a1;
    }
#pragma unroll
    for (int tl = 0; tl < 4; ++tl) { float s = 0.f;
#pragma unroll
        for (int tvi = 0; tvi < 2; ++tvi)
#pragma unroll
            for (int j = 0; j < 4; ++j) s += o[tl][tvi][j] * o[tl][tvi][j];
        s += __shfl_xor(s, 16); s += __shfl_xor(s, 32);
        if (fq == 0) part[w * 64 + 16 * tl + fr] = s; }
    LDS_SYNC();
#pragma unroll
    for (int tl = 0; tl < 4; ++tl) { const int l = 16 * tl + fr; float tot = 0.f;
#pragma unroll
        for (int w8 = 0; w8 < 8; ++w8) tot += part[w8 * 64 + l];
        const float rstd = 1.f / sqrtf(tot * (1.f / 256.f) + EPS);
#pragma unroll
        for (int tvi = 0; tvi < 2; ++tvi) { const int v0 = 16 * (2 * w + tvi) + 4 * fq; const v2u rr = rrv[tl][tvi]; const f32x4 gg = *(const f32x4*)(gng + v0);
            const f32x4 ov = o[tl][tvi];
            *(v2u*)(MX + (size_t)(t0 + l) * 2048 + 1024 + h * 256 + v0) = (v2u){pk2(ov[0] * rstd * gg.x * silu_f(bflo(rr.x)), ov[1] * rstd * gg.y * silu_f(bfhi(rr.x))), pk2(ov[2] * rstd * gg.z * silu_f(bflo(rr.y)), ov[3] * rstd * gg.w * silu_f(bfhi(rr.y)))}; } }
    LDS_SYNC();
}
__device__ __forceinline__ void lds_put16(ldsp base, int off, unsigned v) { *(LAS unsigned short*)(base + off) = (unsigned short)v; }
typedef short v4s __attribute__((ext_vector_type(4)));
__device__ __forceinline__ bf16x8 ldfrag_tr(ldsp tile, int stride, int kbase, int c0, int lane) {
    const int g = lane >> 4, q = (lane >> 2) & 3, p = lane & 3;
    ldsp ad = tile + (kbase + 8 * g + q) * stride + (c0 + 4 * p) * 2;
    const v4s lo = __builtin_amdgcn_ds_read_tr16_b64_v4i16((LAS v4s*)ad), hi = __builtin_amdgcn_ds_read_tr16_b64_v4i16((LAS v4s*)(ad + 4 * stride));
    return __builtin_shufflevector(lo, hi, 0, 1, 2, 3, 4, 5, 6, 7);
}
__device__ __forceinline__ void glds16(const char* g, ldsp l) { __builtin_amdgcn_global_load_lds((const unsigned*)g, (LAS unsigned*)l, 16, 0, 0); }
__device__ __forceinline__ void glds4(const char* g, ldsp l) { __builtin_amdgcn_global_load_lds((const unsigned*)g, (LAS unsigned*)l, 4, 0, 0); }
template <int N> __device__ __forceinline__ void wait_vm() { asm volatile("s_waitcnt vmcnt(%0)" :: "n"(N) : "memory"); }
struct TrFrag { v2u lo, hi; };
template <int OFF> __device__ __forceinline__ v2u ds_tr_b64(unsigned addr) { v2u r; asm volatile("ds_read_b64_tr_b16 %0, %1 offset:%2" : "=v"(r) : "v"(addr), "n"(OFF) : "memory"); return r; }
template <int KB, int TOFF> __device__ __forceinline__ TrFrag tr256(unsigned sbase, int c0, int lane) {
    const int g = lane >> 4, q = (lane >> 2) & 3, p = lane & 3, col = (c0 + 4 * p) * 2;
    const unsigned ad = sbase + (unsigned)((8 * g + q) * 256 + ((((col >> 4) ^ ((q | ((g & 1) << 2)) << 1)) << 4) | (col & 15)));
    TrFrag f; f.lo = ds_tr_b64<TOFF + KB * 256>(ad); f.hi = ds_tr_b64<TOFF + KB * 256 + 1024>(ad); return f;
}
template <int KB, int TOFF> __device__ __forceinline__ TrFrag tr128(unsigned sbase, int c0, int lane) {
    const int g = lane >> 4, q = (lane >> 2) & 3, p = lane & 3, col = (c0 + 4 * p) * 2;
    const unsigned ad = sbase + (unsigned)((8 * g + q) * 128 + ((((col >> 4) ^ (((q >> 1) | ((g & 1) << 1)) << 1)) << 4) | (col & 15)));
    TrFrag f; f.lo = ds_tr_b64<TOFF + KB * 128>(ad); f.hi = ds_tr_b64<TOFF + KB * 128 + 512>(ad); return f;
}
__device__ __forceinline__ bf16x8 frag8(const TrFrag& f) { return __builtin_bit_cast(bf16x8, (v4u){f.lo.x, f.lo.y, f.hi.x, f.hi.y}); }
#define TR_TIE5(f0, f1, f2, f3, f4) asm volatile("s_waitcnt lgkmcnt(0)" : "+v"(f0.lo), "+v"(f0.hi), "+v"(f1.lo), "+v"(f1.hi), "+v"(f2.lo), "+v"(f2.hi), "+v"(f3.lo), "+v"(f3.hi), "+v"(f4.lo), "+v"(f4.hi) :: "memory")
constexpr int CH_DP = 5, CH_SLOT = 25600, CH_NL = 7, CH_STG = CH_DP * CH_SLOT, CH_STG_BYTES = 64 * 272, CH_DUMP = CH_STG + 2 * CH_STG_BYTES + 128, CH_WARM = 6;
__device__ __forceinline__ void ch_stage_state(ldsp stg, const f32x4 (&S)[2][4], int w, int fr, int fq) {
#pragma unroll
    for (int rb = 0; rb < 2; ++rb)
#pragma unroll
        for (int t = 0; t < 4; ++t) *(LAS v2u*)(stg + (16 * t + fr) * 272 + (32 * w + 16 * rb + 4 * fq) * 2) = (v2u){pk2(S[rb][t][0], S[rb][t][1]), pk2(S[rb][t][2], S[rb][t][3])};
}
__device__ __forceinline__ void ch_store_state(ldsp stg, char* dst, int t) {
    v4u r[4];
#pragma unroll
    for (int i = 0; i < 4; ++i) { const int id = i * 256 + t; r[i] = *(const LAS v4u*)(stg + (id >> 4) * 272 + (id & 15) * 16); }
#pragma unroll
    for (int i = 0; i < 4; ++i) *(v4u*)(dst + (size_t)(i * 256 + t) * 16) = r[i];
}
__device__ __forceinline__ void st_ssd_chain(const Args& a, Frame& F, int id) {
    const int b = id >> 4, h = id & 15, g = h >> 3, w = F.wave, lane = F.lane, fr = lane & 15, fq = lane >> 4;
    const char* XA = (const char*)a.out; const char* SW = (const char*)(a.ws + WS_SW); const float* SCD = (const float*)(a.ws + WS_SCD); char* SS = (char*)(a.ws + WS_SS);
    LAS float* dect = (LAS float*)(F.lds + CH_STG + 2 * CH_STG_BYTES);
    if (F.tid < 32) dect[F.tid] = SCD[(b * 32 + F.tid) * 16 + h];
    if (w >= 4) {
        const int t = F.tid - 256;
        const unsigned owarm = (t < 128) ? (unsigned)((t >> 1) * 3072 + (1024 + g * 128) * 2 + (t & 1) * 128) : (t < 192) ? (unsigned)((t - 128) * 3072 + h * 128) : 0xffffffffu;
        for (int hs = 0; hs <= 62; ++hs) {
            LDS_SYNC();
            if ((hs & 1) == 0) { const int c = hs >> 1; ch_store_state(F.lds + CH_STG + (c & 1) * CH_STG_BYTES, SS + ((size_t)((b * 32 + c) * 16 + h)) * 16384, t); }
            { const int hw = hs + CH_WARM <= 61 ? hs + CH_WARM : 61; const int t0 = b * SEQ + hw * 64;
              const char* wp = (owarm != 0xffffffffu) ? XA + (size_t)t0 * 3072 + owarm : SW + (size_t)t0 * 64 + (unsigned)(((t - 192) & 31) * 128 + h * 4);
              glds4(wp, F.lds + CH_DUMP); }
        }
        LDS_SYNC();
        return;
    }
    unsigned ob[4], ox[2], owv;
#pragma unroll
    for (int i = 0; i < 4; ++i) { const int A = (i * 4 + w) * 1024 + lane * 16, row = A >> 8, lc = ((A >> 4) & 15) ^ swz256(row); ob[i] = (unsigned)(row * 3072 + (1024 + g * 128) * 2 + lc * 16); }
#pragma unroll
    for (int i = 0; i < 2; ++i) { const int A = (i * 4 + w) * 1024 + lane * 16, row = A >> 7, lc = ((A >> 4) & 7) ^ swz128(row); ox[i] = (unsigned)(row * 3072 + h * 128 + lc * 16); }
    owv = (unsigned)((lane * 16 + h) * 4);
    auto issue = [&](int hs, int slot) {
        const int t0 = b * SEQ + hs * 64; const char* xb = XA + (size_t)t0 * 3072; const char* wb = SW + (size_t)t0 * 64; ldsp s = F.lds + slot * CH_SLOT;
#pragma unroll
        for (int i = 0; i < 4; ++i) glds16(xb + ob[i], s + (i * 4 + w) * 1024);
#pragma unroll
        for (int i = 0; i < 2; ++i) glds16(xb + ox[i], s + 16384 + (i * 4 + w) * 1024);
        glds4(wb + owv, s + 24576);
    };
    f32x4 S[2][4];
#pragma unroll
    for (int rb = 0; rb < 2; ++rb)
#pragma unroll
        for (int tp = 0; tp < 4; ++tp) S[rb][tp] = (f32x4){0.f, 0.f, 0.f, 0.f};
    asm volatile("s_waitcnt vmcnt(0)" ::: "memory");
#pragma unroll
    for (int j = 0; j < CH_DP - 1; ++j) issue(j, j);
    int slot = 0, nslot = CH_DP - 1;
    for (int hs = 0; hs <= 62; ++hs) {
        const int c = hs >> 1;
        if ((hs & 1) == 0) ch_stage_state(F.lds + CH_STG + (c & 1) * CH_STG_BYTES, S, w, fr, fq);
        wait_vm<(CH_DP - 2) * CH_NL>();
        LDS_SYNC();
        if (hs == 62) break;
        { const int hn = hs + CH_DP - 1; issue(hn <= 61 ? hn : 61, nslot); }
        ldsp s = F.lds + slot * CH_SLOT; const unsigned sb = (unsigned)(size_t)s;
        TrFrag Bq[2][2], xq[2][4];
#pragma unroll
        for (int rb = 0; rb < 2; ++rb) { Bq[0][rb] = tr256<0, 0>(sb, 32 * w + 16 * rb, lane); Bq[1][rb] = tr256<32, 0>(sb, 32 * w + 16 * rb, lane); }
#pragma unroll
        for (int tp = 0; tp < 4; ++tp) { xq[0][tp] = tr128<0, 16384>(sb, 16 * tp, lane); xq[1][tp] = tr128<32, 16384>(sb, 16 * tp, lane); }
        if ((hs & 1) == 0) { const float dec = dect[c];
#pragma unroll
            for (int rb = 0; rb < 2; ++rb)
#pragma unroll
                for (int tp = 0; tp < 4; ++tp) S[rb][tp] = S[rb][tp] * dec; }
        TR_TIE5(Bq[0][0], Bq[0][1], Bq[1][0], Bq[1][1], xq[0][0]); TR_TIE5(xq[0][1], xq[0][2], xq[0][3], xq[1][0], xq[1][1]);
        asm volatile("s_waitcnt lgkmcnt(0)" : "+v"(xq[1][2].lo), "+v"(xq[1][2].hi), "+v"(xq[1][3].lo), "+v"(xq[1][3].hi) :: "memory");
#pragma unroll
        for (int ks = 0; ks < 2; ++ks) {
            const f32x4 w0 = *(const LAS f32x4*)(s + 24576 + (32 * ks + 8 * fq) * 4), w1 = *(const LAS f32x4*)(s + 24576 + (32 * ks + 8 * fq + 4) * 4);
#pragma unroll
            for (int rb = 0; rb < 2; ++rb) {
                const v4u bw = {Bq[ks][rb].lo.x, Bq[ks][rb].lo.y, Bq[ks][rb].hi.x, Bq[ks][rb].hi.y};
                const v4u bs = {pk2(bflo(bw.x) * w0.x, bfhi(bw.x) * w0.y), pk2(bflo(bw.y) * w0.z, bfhi(bw.y) * w0.w), pk2(bflo(bw.z) * w1.x, bfhi(bw.z) * w1.y), pk2(bflo(bw.w) * w1.z, bfhi(bw.w) * w1.w)};
                const bf16x8 Bf = __builtin_bit_cast(bf16x8, bs);
#pragma unroll
                for (int tp = 0; tp < 4; ++tp) S[rb][tp] = MFMA16(Bf, frag8(xq[ks][tp]), S[rb][tp]); } }
        slot = (slot + 1 == CH_DP) ? 0 : slot + 1; nslot = (nslot + 1 == CH_DP) ? 0 : nslot + 1;
    }
    wait_vm<0>();
    LDS_SYNC();
}
__device__ __forceinline__ void st_gla_chain(const Args& a, Frame& F, int id) {
    const int b = id >> 4, h = (id >> 2) & 3, vq = id & 3, w = F.wave, lane = F.lane, fr = lane & 15, fq = lane >> 4;
    const char* KD = (const char*)(a.ws + WS_KD); const char* P = (const char*)(a.ws + WS_PROJ); const char* DKL = (const char*)(a.ws + WS_DKL); char* GS = (char*)(a.ws + WS_GS);
    if (w >= 4) {
        const int t = F.tid - 256;
        for (int c = 0; c <= 63; ++c) {
            LDS_SYNC();
            ch_store_state(F.lds + CH_STG + (c & 1) * CH_STG_BYTES, GS + (((size_t)((b * 64 + c) * 4 + h)) * 256 + vq * 64) * 256, t);
            { const int cw = c + CH_WARM <= 62 ? c + CH_WARM : 62; const int t0 = b * SEQ + cw * 64;
              const char* wp = (t < 128) ? KD + (size_t)(t0 + (t >> 1)) * 1024 + h * 256 + (t & 1) * 128
                             : (t < 192) ? P + (size_t)(t0 + (t - 128)) * (NIN * 2) + (PV + h * 256 + vq * 64) * 2
                                         : DKL + ((size_t)(b * 64 + cw) * 512 + h * 128) * 4 + ((t - 192) & 3) * 128;
              glds4(wp, F.lds + CH_DUMP); }
        }
        LDS_SYNC();
        return;
    }
    unsigned okd[4], ov[2];
#pragma unroll
    for (int i = 0; i < 4; ++i) { const int A = (i * 4 + w) * 1024 + lane * 16, row = A >> 8, lc = ((A >> 4) & 15) ^ swz256(row); okd[i] = (unsigned)(row * 1024 + h * 256 + lc * 16); }
#pragma unroll
    for (int i = 0; i < 2; ++i) { const int A = (i * 4 + w) * 1024 + lane * 16, row = A >> 7, lc = ((A >> 4) & 7) ^ swz128(row); ov[i] = (unsigned)(row * (NIN * 2) + (PV + h * 256 + vq * 64) * 2 + lc * 16); }
    auto issue = [&](int c, int slot) {
        const int t0 = b * SEQ + c * 64; const char* kb = KD + (size_t)t0 * 1024; const char* pb = P + (size_t)t0 * (NIN * 2); const char* db = DKL + ((size_t)(b * 64 + c) * 512 + h * 128) * 4; ldsp s = F.lds + slot * CH_SLOT;
#pragma unroll
        for (int i = 0; i < 4; ++i) glds16(kb + okd[i], s + (i * 4 + w) * 1024);
#pragma unroll
        for (int i = 0; i < 2; ++i) glds16(pb + ov[i], s + 16384 + (i * 4 + w) * 1024);
        glds16(db + lane * 16, s + 24576);
    };
    f32x4 S[2][4];
#pragma unroll
    for (int rb = 0; rb < 2; ++rb)
#pragma unroll
        for (int tv = 0; tv < 4; ++tv) S[rb][tv] = (f32x4){0.f, 0.f, 0.f, 0.f};
    asm volatile("s_waitcnt vmcnt(0)" ::: "memory");
#pragma unroll
    for (int j = 0; j < CH_DP - 1; ++j) issue(j, j);
    int slot = 0, nslot = CH_DP - 1;
    for (int c = 0; c <= 63; ++c) {
        ch_stage_state(F.lds + CH_STG + (c & 1) * CH_STG_BYTES, S, w, fr, fq);
        wait_vm<(CH_DP - 2) * CH_NL>();
        LDS_SYNC();
        if (c == 63) break;
        { const int cn = c + CH_DP - 1; issue(cn <= 62 ? cn : 62, nslot); }
        ldsp s = F.lds + slot * CH_SLOT; const unsigned sb = (unsigned)(size_t)s;
        TrFrag Kq[2][2], vq2[2][4];
#pragma unroll
        for (int rb = 0; rb < 2; ++rb) { Kq[0][rb] = tr256<0, 0>(sb, 32 * w + 16 * rb, lane); Kq[1][rb] = tr256<32, 0>(sb, 32 * w + 16 * rb, lane); }
#pragma unroll
        for (int tv = 0; tv < 4; ++tv) { vq2[0][tv] = tr128<0, 16384>(sb, 16 * tv, lane); vq2[1][tv] = tr128<32, 16384>(sb, 16 * tv, lane); }
#pragma unroll
        for (int rb = 0; rb < 2; ++rb) { const f32x4 dk4 = *(const LAS f32x4*)(s + 24576 + (32 * w + 16 * rb + 4 * fq) * 4);
#pragma unroll
            for (int tv = 0; tv < 4; ++tv) S[rb][tv] = S[rb][tv] * dk4; }
        TR_TIE5(Kq[0][0], Kq[0][1], Kq[1][0], Kq[1][1], vq2[0][0]); TR_TIE5(vq2[0][1], vq2[0][2], vq2[0][3], vq2[1][0], vq2[1][1]);
        asm volatile("s_waitcnt lgkmcnt(0)" : "+v"(vq2[1][2].lo), "+v"(vq2[1][2].hi), "+v"(vq2[1][3].lo), "+v"(vq2[1][3].hi) :: "memory");
#pragma unroll
        for (int ks = 0; ks < 2; ++ks)
#pragma unroll
            for (int rb = 0; rb < 2; ++rb)
#pragma unroll
                for (int tv = 0; tv < 4; ++tv) S[rb][tv] = MFMA16(frag8(Kq[ks][rb]), frag8(vq2[ks][tv]), S[rb][tv]);
        slot = (slot + 1 == CH_DP) ? 0 : slot + 1; nslot = (nslot + 1 == CH_DP) ? 0 : nslot + 1;
    }
    wait_vm<0>();
    LDS_SYNC();
}
__device__ __forceinline__ void phase6b_range(const Args& a, Frame& F, int cw, int ncw);
__device__ __forceinline__ void phase6b_tickets(const Args& a, Frame& F);
constexpr int CV_DP = 4, CV_SLOT = 32768, CV_T = CV_DP * CV_SLOT, CV_TB = 64 * 144, CV_STEPS = 96 * 128;
#ifndef CV_OWNER_STEPS
#define CV_OWNER_STEPS 24
#endif
constexpr int CV_EARLY_WGS = 64, CV_EARLY_STEPS = 20, CV_EARLY = CV_EARLY_WGS * CV_EARLY_STEPS;
__device__ __forceinline__ void cv_mat(int m, int& e, int& kind) { if (m < 48) { e = m >> 1; kind = m & 1; } else if (m < 80) { e = m - 48; kind = 2; } else { e = 24 + ((m - 80) >> 1); kind = (m - 80) & 1; } }
__device__ __forceinline__ void cvt_stream(const Args& a, Frame& F, int sid0, int stride, int nst);
__device__ __forceinline__ void phase_states(const Args& a, Frame& F) {
    for (int r = F.vcu; r < 256; r += F.G) {
        const int xcd = r >> 5, idx = r & 31;
        if (idx < 8) st_ssd_chain(a, F, xcd * 8 + idx);
        else if (idx < 16) st_gla_chain(a, F, xcd * 8 + idx - 8);
        { constexpr int REST = CV_STEPS - CV_EARLY, NOWN = 128 * CV_OWNER_STEPS, NOTH = (REST - NOWN) / 128; static_assert((REST - NOWN) % 128 == 0, "tile split");
          const int j = xcd * 16 + (idx & 15);
          if (idx < 16) cvt_stream(a, F, CV_EARLY + 128 * NOTH + j, 128, CV_OWNER_STEPS); else cvt_stream(a, F, CV_EARLY + j, 128, NOTH); }
    }
}
__device__ __forceinline__ void phase4a(const Args& a, Frame& F) { for (int it = F.vcu; it < 1280; it += F.G) { if (it < 256) p4a_ssd(a, F, it); else p4a_gla(a, F, it - 256); } }
__device__ __forceinline__ void phase4c(const Args& a, Frame& F) {
    int it = F.vcu;
    for (; it < 256; it += F.G) p4c_ssd(a, F, it);
    if (it < 1280) {
        GlaStage S; gla_stage_load(S, a, F, it - 256);
        for (; it < 1280; it += F.G) p4c_gla(a, F, it - 256, S, (it + F.G < 1280) ? it + F.G - 256 : -1); }
}
__device__ __forceinline__ void phase6(const Args& a, Frame& F) {
    const float* X1 = a.out; const float* g2 = a.in[16]; const float* wr = a.in[17]; const float* br = a.in[18]; const float* mod = (const float*)(a.ws + WS_MOD);
    bf16* X1B = (bf16*)(a.ws + WS_X1B); bf16* H2 = (bf16*)(a.ws + WS_H2); unsigned* cntw = (unsigned*)(a.ws + WS_CTL) + CW_CNT; unsigned* list = (unsigned*)(a.ws + WS_LIST);
    const int gw = F.vcu * 8 + F.wave, NGW = F.G * 8;
    LAS float* wl = (LAS float*)F.lds;
    LAS unsigned* lcnt = (LAS unsigned*)(F.lds + 147456);
    LAS unsigned* lbase = lcnt + 32; LAS unsigned* lent = lcnt + 64; LAS unsigned* ltok = lent + 1024;
    if (F.tid < 32) lcnt[F.tid] = 0u;
    const int nmax = (T + NGW - 1) / NGW;
    for (int s = F.tid; s < nmax * 32; s += 512) lent[s] = 0xffffffffu;
    int nloc = 0;
#pragma unroll 4
    for (int i = F.tid; i < 8192; i += 512) { const int d = i >> 3, q = i & 7, pd = (d & ~255) + 64 * (d & 3) + ((d >> 2) & 63); *(LAS f32x4*)(wl + pd * WR_STRIDE + 4 * q) = *(const f32x4*)(wr + d * 32 + 4 * q); }
    __syncthreads();
    float Gm[16], Sh[16]; int bprev = -1;
    f32x4 nx[4];
    if (gw < T) {
#pragma unroll
        for (int j = 0; j < 4; ++j) nx[j] = *(const f32x4*)(X1 + (size_t)gw * D + 256 * j + 4 * F.lane); }
    for (int m = gw; m < T; m += NGW) {
        const int b = m / SEQ; float hv[16]; float ss = 0.f;
#pragma unroll
        for (int j = 0; j < 4; ++j) { hv[4 * j] = nx[j].x; hv[4 * j + 1] = nx[j].y; hv[4 * j + 2] = nx[j].z; hv[4 * j + 3] = nx[j].w; }
#pragma unroll
        for (int j = 0; j < 4; ++j) *(v2u*)(X1B + (size_t)m * D + 256 * j + 4 * F.lane) = (v2u){pk2(nx[j].x, nx[j].y), pk2(nx[j].z, nx[j].w)};
        if (m + NGW < T) {
#pragma unroll
            for (int j = 0; j < 4; ++j) nx[j] = *(const f32x4*)(X1 + (size_t)(m + NGW) * D + 256 * j + 4 * F.lane); }
        if (b != bprev) { bprev = b;
#pragma unroll
            for (int jj = 0; jj < 16; ++jj) { const int d = 256 * (jj >> 2) + 4 * F.lane + (jj & 3); Gm[jj] = g2[d] * (1.f + mod[b * 6144 + 4096 + d]); Sh[jj] = mod[b * 6144 + 3072 + d]; } }
#pragma unroll
        for (int jj = 0; jj < 16; ++jj) ss += hv[jj] * hv[jj];
        const float rstd = 1.f / sqrtf(wave_sum(ss) * (1.f / D) + EPS);
#pragma unroll
        for (int jj = 0; jj < 16; ++jj) hv[jj] = hv[jj] * rstd * Gm[jj] + Sh[jj];
#pragma unroll
        for (int j = 0; j < 4; ++j) {
            if (MOE_FP8) *(unsigned*)((unsigned char*)H2 + (size_t)m * D + 256 * j + 4 * F.lane) = pk4_fp8(hv[4 * j], hv[4 * j + 1], hv[4 * j + 2], hv[4 * j + 3]);
            else *(v2u*)(H2 + (size_t)m * D + 256 * j + 4 * F.lane) = (v2u){pk2(hv[4 * j], hv[4 * j + 1]), pk2(hv[4 * j + 2], hv[4 * j + 3])}; }
        float acc[32];
#pragma unroll
        for (int e = 0; e < 32; ++e) acc[e] = 0.f;
#pragma unroll
        for (int jj = 0; jj < 16; ++jj) { const int pd = 256 * (jj >> 2) + 64 * (jj & 3) + F.lane; const LAS f32x4* wp = (const LAS f32x4*)(wl + pd * WR_STRIDE); const float h = hv[jj];
#pragma unroll
            for (int q = 0; q < 8; ++q) { const f32x4 w = wp[q]; acc[4 * q] += h * w.x; acc[4 * q + 1] += h * w.y; acc[4 * q + 2] += h * w.z; acc[4 * q + 3] += h * w.w; }
            if (jj & 1) asm volatile("" ::: "memory"); }
#pragma unroll
        for (int e = 0; e < 32; ++e) acc[e] += __shfl_xor(acc[e], 32);
        { const bool hi = (F.lane & 16) != 0;
#pragma unroll
          for (int i = 0; i < 16; ++i) { const float send = hi ? acc[i] : acc[i + 16], keep = hi ? acc[i + 16] : acc[i]; acc[i] = keep + __shfl_xor(send, 16); } }
        { const bool hi = (F.lane & 8) != 0;
#pragma unroll
          for (int i = 0; i < 8; ++i) { const float send = hi ? acc[i] : acc[i + 8], keep = hi ? acc[i + 8] : acc[i]; acc[i] = keep + __shfl_xor(send, 8); } }
        { const bool hi = (F.lane & 4) != 0;
#pragma unroll
          for (int i = 0; i < 4; ++i) { const float send = hi ? acc[i] : acc[i + 4], keep = hi ? acc[i + 4] : acc[i]; acc[i] = keep + __shfl_xor(send, 4); } }
        { const bool hi = (F.lane & 2) != 0;
#pragma unroll
          for (int i = 0; i < 2; ++i) { const float send = hi ? acc[i] : acc[i + 2], keep = hi ? acc[i + 2] : acc[i]; acc[i] = keep + __shfl_xor(send, 2); } }
        { const bool hi = (F.lane & 1) != 0; const float send = hi ? acc[0] : acc[1], keep = hi ? acc[1] : acc[0]; acc[0] = keep + __shfl_xor(send, 1); }
        const int e_me = F.lane & 31;
        float lv = acc[0] + br[e_me];
        float tv[4]; int ti[4];
#pragma unroll
        for (int k = 0; k < 4; ++k) {
            float mx = lv;
#pragma unroll
            for (int o = 1; o < 32; o <<= 1) mx = fmaxf(mx, __shfl_xor(mx, o));
            const unsigned long long bal = __ballot(lv == mx) & 0xffffffffull;
            const int idx = __builtin_ctzll(bal);
            tv[k] = mx; ti[k] = idx;
            if (e_me == idx) lv = -3.0e38f;
        }
        const float e1 = __expf(tv[1] - tv[0]), e2 = __expf(tv[2] - tv[0]), e3 = __expf(tv[3] - tv[0]); const float inv = 1.f / (1.f + e1 + e2 + e3);
        if (F.lane < 4) {
            const int k = F.lane; const int e = (k == 0) ? ti[0] : (k == 1) ? ti[1] : (k == 2) ? ti[2] : ti[3];
            const float w = ((k == 0) ? 1.f : (k == 1) ? e1 : (k == 2) ? e2 : e3) * inv;
            const unsigned lr = __hip_atomic_fetch_add(&lcnt[e], 1u, __ATOMIC_RELAXED, __HIP_MEMORY_SCOPE_WORKGROUP);
            const int slot = (nloc * 8 + F.wave) * 4 + k;
            lent[slot] = ((unsigned)e << 24) | lr; ltok[slot] = (unsigned)(m * 4 + k) | ((unsigned)__builtin_bit_cast(unsigned short, (_Float16)w) << 16);
        }
        ++nloc;
    }
    __syncthreads();
    if (F.tid < 32) lbase[F.tid] = atomicAdd(&cntw[F.tid * CNT_STRIDE], lcnt[F.tid]);
    __syncthreads();
    for (int s = F.tid; s < nmax * 32; s += 512) { const unsigned en = lent[s]; if (en != 0xffffffffu) { const unsigned e = en >> 24, lr = en & 0xffffffu; list[e * LCAP + lbase[e] + lr] = ltok[s]; } }
}
__device__ __forceinline__ void phase6b_range(const Args& a, Frame& F, int cw, int ncw) {
    for (int it = cw; it < 96 * 512; it += ncw) {
        const int mat = it >> 9, sub = it & 511, e = mat / 3, kind = mat % 3;
        if (kind == 0) transpose_item_f8(a.in[19] + (size_t)e * 1048576, 1024, 1024, a.ws + w1_off(e), sub, F.lane, MapGU{0});
        else if (kind == 1) transpose_item_f8(a.in[21] + (size_t)e * 1048576, 1024, 1024, a.ws + w1_off(e), sub, F.lane, MapGU{1});
        else transpose_item_f8(a.in[23] + (size_t)e * 1048576, 1024, 1024, a.ws + w2_off(e), sub, F.lane, MapId());
    }
}
__device__ __forceinline__ void phase6b(const Args& a, Frame& F) { phase6b_range(a, F, F.vcu * 8 + F.wave, F.G * 8); }
__device__ __forceinline__ void phase6b_tickets(const Args& a, Frame& F) {
    unsigned* ctr = (unsigned*)(a.ws + WS_CTL) + CW_CVT;
    for (;;) {
        unsigned base = 0u; if (F.lane == 0) base = atomicAdd(ctr, 16u);
        base = (unsigned)__builtin_amdgcn_readfirstlane((int)base);
        if (base >= 96u * 512u) break;
        for (int it = (int)base; it < (int)base + 16; ++it) {
            const int mat = it >> 9, sub = it & 511, e = mat / 3, kind = mat % 3;
            if (kind == 0) transpose_item_f8(a.in[19] + (size_t)e * 1048576, 1024, 1024, a.ws + w1_off(e), sub, F.lane, MapGU{0});
            else if (kind == 1) transpose_item_f8(a.in[21] + (size_t)e * 1048576, 1024, 1024, a.ws + w1_off(e), sub, F.lane, MapGU{1});
            else transpose_item_f8(a.in[23] + (size_t)e * 1048576, 1024, 1024, a.ws + w2_off(e), sub, F.lane, MapId());
        }
    }
}
__device__ __forceinline__ void cvt_stream(const Args& a, Frame& F, int sid0, int stride, int nst) {
    const int w = F.wave, lane = F.lane;
    if (w < 4) {
        unsigned og[8];
#pragma unroll
        for (int i = 0; i < 8; ++i) { const int A = (i * 4 + w) * 1024 + lane * 16, row = A >> 8, lc = ((A >> 4) & 15) ^ (((row >> 3) & 1) << 3); og[i] = (unsigned)(row * 4096 + lc * 16); }
        auto issue = [&](int i, int slot) {
            const int sid = sid0 + stride * (i < nst ? i : nst - 1), r = sid & 127, kb2 = r >> 4, nb = r & 15; int e, kind; cv_mat(sid >> 7, e, kind);
            const float* W = (kind == 0 ? a.in[19] : kind == 1 ? a.in[21] : a.in[23]) + (size_t)e * 1048576;
            const char* src = (const char*)(W + (size_t)kb2 * 128 * 1024 + nb * 64); ldsp sl = F.lds + slot * CV_SLOT;
#pragma unroll
            for (int k = 0; k < 8; ++k) __builtin_amdgcn_global_load_lds((const unsigned*)(src + og[k]), (LAS unsigned*)(sl + (k * 4 + w) * 1024), 16, 0, 2);
        };
        const int a2 = w >> 1, b2 = w & 1, q = lane >> 3, l = lane & 7;
        asm volatile("s_waitcnt vmcnt(0)" ::: "memory");
#pragma unroll
        for (int i = 0; i < CV_DP - 1; ++i) issue(i, i);
        for (int s = 0; s <= nst; ++s) {
            if (s < nst) wait_vm<(CV_DP - 2) * 8>();
            LDS_SYNC();
            if (s == nst) break;
            issue(s + CV_DP - 1, (s + CV_DP - 1) & (CV_DP - 1));
            ldsp sl = F.lds + (s & (CV_DP - 1)) * CV_SLOT; ldsp T = F.lds + CV_T + (s & 1) * CV_TB;
            f32x4 v[8];
#pragma unroll
            for (int jj = 0; jj < 8; ++jj) v[jj] = *(const LAS f32x4*)(sl + (a2 * 64 + 8 * q + jj) * 256 + (((b2 * 8 + l) ^ ((q & 1) << 3)) << 4));
#pragma unroll
            for (int i = 0; i < 4; ++i)
                *(LAS v2u*)(T + (b2 * 32 + 4 * l + i) * 144 + a2 * 64 + 8 * q) = (v2u){pk4_fp8(32.f * v[0][i], 32.f * v[1][i], 32.f * v[2][i], 32.f * v[3][i]), pk4_fp8(32.f * v[4][i], 32.f * v[5][i], 32.f * v[6][i], 32.f * v[7][i])};
        }
        wait_vm<0>();
    } else {
        const int t = F.tid - 256;
        for (int s = 0; s <= nst; ++s) {
            LDS_SYNC();
            if (s > 0) {
                const int sid = sid0 + stride * (s - 1), r = sid & 127, kb2 = r >> 4, nb = r & 15, n0 = nb * 64; int e, kind; cv_mat(sid >> 7, e, kind);
                unsigned char* dst = a.ws + (kind < 2 ? w1_off(e) : w2_off(e)) + (size_t)(kind < 2 ? 256 * (n0 >> 7) + 128 * kind + (n0 & 127) : n0) * 1024 + kb2 * 128;
                ldsp T = F.lds + CV_T + ((s - 1) & 1) * CV_TB;
                v4u d[2];
#pragma unroll
                for (int rr = 0; rr < 2; ++rr) { const int id = t + 256 * rr; d[rr] = *(const LAS v4u*)(T + (id >> 3) * 144 + (id & 7) * 16); }
#pragma unroll
                for (int rr = 0; rr < 2; ++rr) { const int id = t + 256 * rr; *(GAS v4u*)(dst + (size_t)(id >> 3) * 1024 + (id & 7) * 16) = d[rr]; }
            }
        }
    }
    LDS_SYNC();
}
__device__ __forceinline__ int moe_table(const Args& a, Frame& F) {
    LAS int* cnt = (LAS int*)(F.lds + TAB_OFF); LAS int* tstart = cnt + 32;
    const unsigned* cntw = (const unsigned*)(a.ws + WS_CTL) + CW_CNT;
    if (F.tid < 32) cnt[F.tid] = (int)__hip_atomic_load(cntw + F.tid * CNT_STRIDE, RLX_AGENT);
    __syncthreads();
    if (F.tid == 0) { int s = 0; for (int e = 0; e < 32; ++e) { tstart[e] = s; s += (cnt[e] + 255) >> 8; } tstart[32] = s; }
    __syncthreads();
    return tstart[32];
}
__device__ __forceinline__ void phase9(const Args& a, Frame& F, float* XO) {
    float* X = a.out; const bf16* SL = (const bf16*)(a.ws + WS_SLAB); const float* mod = (const float*)(a.ws + WS_MOD); const float* fg = a.in[25];
    const int gw = F.vcu * 8 + F.wave, NGW = F.G * 8;
    const bf16* X1B = (const bf16*)(a.ws + WS_X1B); f32x4 Gt[4], Fg[4]; v2u nx[4]; v2u ns[4][4]; unsigned n8[4][4]; int bprev = -1;
#pragma unroll
    for (int j = 0; j < 4; ++j) Fg[j] = *(const f32x4*)(fg + 4 * F.lane + 256 * j);
    auto ld_row = [&](int m) {
#pragma unroll
        for (int j = 0; j < 4; ++j) { const int d0 = 4 * F.lane + 256 * j; nx[j] = *(const v2u*)(X1B + (size_t)m * D + d0);
#pragma unroll
            for (int k = 0; k < 4; ++k) { if (SLAB_FP8) n8[j][k] = *(const unsigned*)((const unsigned char*)SL + ((size_t)m * 4 + k) * 1024 + d0); else ns[j][k] = *(const v2u*)(SL + ((size_t)m * 4 + k) * 1024 + d0); } }
    };
    if (gw < T) ld_row(gw);
    for (int m = gw; m < T; m += NGW) {
        const int b = m / SEQ; f32x4 v[4]; float s = 0.f;
        if (b != bprev) { bprev = b;
#pragma unroll
            for (int j = 0; j < 4; ++j) Gt[j] = *(const f32x4*)(mod + b * 6144 + 5120 + 4 * F.lane + 256 * j); }
#pragma unroll
        for (int j = 0; j < 4; ++j) { f32x4 f = (f32x4){0.f, 0.f, 0.f, 0.f};
#pragma unroll
            for (int k = 0; k < 4; ++k) {
                if (SLAB_FP8) { const int w8 = (int)n8[j][k]; f.x += __builtin_amdgcn_cvt_f32_fp8(w8, 0); f.y += __builtin_amdgcn_cvt_f32_fp8(w8, 1); f.z += __builtin_amdgcn_cvt_f32_fp8(w8, 2); f.w += __builtin_amdgcn_cvt_f32_fp8(w8, 3); }
                else { const v2u w = ns[j][k]; f.x += bflo(w.x); f.y += bfhi(w.x); f.z += bflo(w.y); f.w += bfhi(w.y); } }
            if (SLAB_FP8) f = f * (1.f / 32.f);
            v[j] = (f32x4){bflo(nx[j].x), bfhi(nx[j].x), bflo(nx[j].y), bfhi(nx[j].y)} + Gt[j] * f; s += (v[j].x * v[j].x + v[j].y * v[j].y) + (v[j].z * v[j].z + v[j].w * v[j].w); }
        if (m + NGW < T) ld_row(m + NGW);
        const float rstd = 1.f / sqrtf(wave_sum(s) * (1.f / D) + EPS);
#pragma unroll
        for (int j = 0; j < 4; ++j) { const int d0 = 4 * F.lane + 256 * j; *(f32x4*)(XO + (size_t)m * D + d0) = v[j] * rstd * Fg[j]; }
    }
}

#define PRB_KREP_IN 1
#define PRB_EPIREP_IN 1
#define PRB_KREP_GU 1
#define PRB_EPIREP_GU 1
#define PRB_KREP_DN 1
#define PRB_EPIREP_DN 1
#define PHASE_LIST X(0) X(1) X(2) X(3) X(17) X(6) X(7) X(8) X(9) X(10) X(11)
#define X(p) +1
constexpr int NPHASE = 0 PHASE_LIST;
#undef X
template <int PH> __device__ __forceinline__ void run_phase(const Args& args, Frame& F) {
    if constexpr (PH == 0) phase0(args, F);
    else if constexpr (PH == 1) phase1(args, F);
    else if constexpr (PH == 2) {
        DenseSched S{T / 256, NIN / 256, F.G, F.vcu, 2048, (const char*)(args.ws + WS_WIN)};
        EpiProj E{(bf16*)(args.ws + WS_PROJ)};
        pg8::gemm_phase<EpiProj, DenseSched, false, true, true, PRB_KREP_IN, PRB_EPIREP_IN>(F.lds, (const char*)(args.ws + WS_H), 2048, S, E);
        { const int nun = (T / 256) * (NIN / 256), full = nun / F.G, rem = nun - full * F.G;
          if (rem > 0 && F.vcu >= rem && F.vcu - rem < CV_EARLY_WGS && F.G - rem >= CV_EARLY_WGS) cvt_stream(args, F, F.vcu - rem, CV_EARLY_WGS, CV_EARLY_STEPS);
          else if (!(rem > 0 && F.G - rem >= CV_EARLY_WGS) && F.vcu < CV_EARLY_WGS) cvt_stream(args, F, F.vcu, CV_EARLY_WGS, CV_EARLY_STEPS); }
    }
    else if constexpr (PH == 3) phase3(args, F);
    else if constexpr (PH == 4) phase4a(args, F);
    else if constexpr (PH == 5) p4b_scan(args, F);
    else if constexpr (PH == 6) phase4c(args, F);
    else if constexpr (PH == 7) {
        DenseSched S{T / 256, D / 256, F.G, F.vcu, 4096, (const char*)(args.ws + WS_WOUT)};
        EpiRes E{args.in[0], args.out, (const float*)(args.ws + WS_MOD)};
        pg8::gemm_phase(F.lds, (const char*)(args.ws + WS_MIX), 4096, S, E);
    }
    else if constexpr (PH == 8) phase6(args, F);
    else if constexpr (PH == 9) {
        const int ntiles = moe_table(args, F);
        const LAS int* cnt = (const LAS int*)(F.lds + TAB_OFF);
        LAS int* toks = (LAS int*)(F.lds + RING_BYTES + 4096);
        moe_tokens(toks, 8, F.G, F.vcu, ntiles, cnt, cnt + 32, (const unsigned*)(args.ws + WS_LIST), F.tid);
        constexpr int EB = MOE_FP8 ? 1 : 2;
        MoeSched<true> S{8, F.G, F.vcu, 1024 * EB, ntiles, cnt, cnt + 32, toks, (const char*)args.ws, 1};
        LAS float* ept = (LAS float*)(F.lds + EPT_OFF);
        moe_epi_gateup(ept, 8, F.G, F.vcu, ntiles, cnt + 32, args.in[20], args.in[22], F.tid);
        EpiGateUp E{(bf16*)(args.ws + WS_ACT), ept};
        pg8::gemm_phase<EpiGateUp, MoeSched<true>, MOE_FP8 != 0, true, true, PRB_KREP_GU, PRB_EPIREP_GU>(F.lds, (const char*)(args.ws + WS_H2), 1024 * EB, S, E);
    }
    else if constexpr (PH == 10) {
        const int ntiles = moe_table(args, F);
        const LAS int* cnt = (const LAS int*)(F.lds + TAB_OFF);
        constexpr int EB = MOE_FP8 ? 1 : 2;
        MoeSched<false> S{4, F.G, F.vcu, 1024 * EB, ntiles, cnt, cnt + 32, nullptr, (const char*)args.ws, 2};
        LAS unsigned* ept = (LAS unsigned*)(F.lds + EPT_OFF);
        moe_epi_down(ept, 4, F.G, F.vcu, ntiles, cnt, cnt + 32, (const unsigned*)(args.ws + WS_LIST), args.in[24], F.tid);
        EpiDown E{(bf16*)(args.ws + WS_SLAB), ept};
        pg8::gemm_phase<EpiDown, MoeSched<false>, MOE_FP8 != 0, true, true, PRB_KREP_DN, PRB_EPIREP_DN>(F.lds, (const char*)(args.ws + WS_ACT), 1024 * EB, S, E);
    }
    else if constexpr (PH == 12) phase6b(args, F);
    else if constexpr (PH == 17) phase_states(args, F);
    else if constexpr (PH == 13) phase9(args, F, (float*)(args.ws + 1 * MiB));
    else if constexpr (PH == 14) { if (F.vcu == 0 && F.tid < 32) ((unsigned*)(args.ws + WS_CTL))[CW_CNT + F.tid * CNT_STRIDE] = 0u; }
    else phase9(args, F, args.out);
}
__global__ void __launch_bounds__(512, 2) mk_fwd(Args args) {
    extern __shared__ __attribute__((aligned(16))) unsigned char lds_raw[];
    Frame F; F.lds = (LAS unsigned char*)lds_raw; F.tid = threadIdx.x; F.lane = F.tid & 63; F.wave = __builtin_amdgcn_readfirstlane(F.tid >> 6);
    F.G = gridDim.x; { const int bx = blockIdx.x; F.vcu = (F.G % 8 == 0) ? (bx % 8) * (F.G / 8) + bx / 8 : bx; }
    volatile LAS unsigned* MISC = (volatile LAS unsigned*)(F.lds + MISC_OFF);
    if (F.tid < 32) MISC[F.tid] = 0u;
    __syncthreads();
    unsigned* ctl = (unsigned*)(args.ws + WS_CTL);
    XcdBarrier bar; bar.bar = ctl + CW_BAR; bar.x = 0; bar.st = nullptr;
    if (MK_N_LAUNCHES == 1) bar = xcd_barrier_post(ctl + CW_BAR, MISC + 8);
    const int lo = args.ph_lo, hi = args.ph_hi; int idx = 0;
#define X(p) { if (lo <= idx && idx < hi) run_phase<p>(args, F); if (lo <= idx && idx + 1 < hi) xcd_barrier(bar); ++idx; }
    PHASE_LIST
#undef X
}

extern "C" void kernel_launch(void* const* d_in, const int* in_sizes, int n_in, void* d_out, int out_size, void* d_ws, size_t ws_size, hipStream_t stream) {
    static int grid = 0;
    if (grid == 0) {
        if (n_in != 26 || out_size != T * D || ws_size < WS_END) { fprintf(stderr, "kernel_launch: unexpected shapes (n_in %d out %d ws %zu)\n", n_in, out_size, ws_size); grid = -1; return; }
        int dev = 0, cus = 0, per_cu = 0;
        if (hipGetDevice(&dev) != hipSuccess || hipDeviceGetAttribute(&cus, hipDeviceAttributeMultiprocessorCount, dev) != hipSuccess) { grid = -1; return; }
        if (hipFuncSetAttribute((const void*)mk_fwd, hipFuncAttributeMaxDynamicSharedMemorySize, LDS_BYTES) != hipSuccess) { fprintf(stderr, "kernel_launch: hipFuncSetAttribute failed\n"); grid = -1; return; }
        if (hipOccupancyMaxActiveBlocksPerMultiprocessor(&per_cu, (const void*)mk_fwd, 512, LDS_BYTES) != hipSuccess || per_cu < 1) { fprintf(stderr, "kernel_launch: occupancy query says %d\n", per_cu); per_cu = 1; }
        (void)hipGetLastError();
        grid = cus;
    }
    if (grid < 0) return;
    (void)hipMemsetAsync((char*)d_ws + WS_CTL, 0, CTL_ZERO_BYTES, stream);
    Args a{};
    for (int i = 0; i < 26; ++i) a.in[i] = (const float*)d_in[i];
    a.out = (float*)d_out; a.ws = (unsigned char*)d_ws;
    if (MK_N_LAUNCHES == 1) { a.ph_lo = 0; a.ph_hi = NPHASE; hipLaunchKernelGGL(mk_fwd, dim3(grid), dim3(512), LDS_BYTES, stream, a); }
    else { for (int p = 0; p < NPHASE; ++p) { a.ph_lo = p; a.ph_hi = p + 1; hipLaunchKernelGGL(mk_fwd, dim3(grid), dim3(512), LDS_BYTES, stream, a); } }
}
```

```cpp
#include <hip/hip_runtime.h>
#include <cstdio>

#ifndef MK_N_LAUNCHES
#define MK_N_LAUNCHES 1
#endif

#ifndef SLAB_FP8
#define SLAB_FP8 1
#endif
#ifndef MOE_FP8
#define MOE_FP8 1
#endif
#define GAS __attribute__((address_space(1)))
#define LAS __attribute__((address_space(3)))
typedef unsigned short bf16;
typedef unsigned v4u __attribute__((ext_vector_type(4)));
typedef unsigned v2u __attribute__((ext_vector_type(2)));
typedef float f32x4 __attribute__((ext_vector_type(4)));
typedef short bf16x8 __attribute__((ext_vector_type(8)));
typedef int v4i __attribute__((ext_vector_type(4)));
typedef int v8i __attribute__((ext_vector_type(8)));
#define RLX_AGENT __ATOMIC_RELAXED, __HIP_MEMORY_SCOPE_AGENT
#define LDS_WAIT() asm volatile("s_waitcnt lgkmcnt(0)" ::: "memory")
#define VM_WAIT() asm volatile("s_waitcnt vmcnt(0)" ::: "memory")

constexpr int NB = 4, SEQ = 4096, T = NB * SEQ, D = 1024;
constexpr int NIN = 5888;
constexpr int PZ = 0, PX = 1024, PBM = 2048, PCM = 2304, PQ = 2560, PK = 3072, PV = 3584, PR = 4608, PDT = 5632, PGL = 5648;
constexpr int NE = 32, TOPK = 4, LCAP = 16384;
constexpr int MAXTILES = 288;
constexpr float EPS = 1e-6f;

constexpr size_t MiB = 1u << 20;
constexpr size_t WS_CTL = 0, CTL_ZERO_BYTES = 65536;
constexpr size_t WS_MOD = 65536;
constexpr size_t WS_ROWW = 262144;
constexpr size_t WS_WIN = 1 * MiB, WS_WOUT = 13 * MiB;
constexpr size_t WS_H = 17 * MiB;
constexpr size_t WS_PROJ = 49 * MiB;
constexpr size_t WS_GK = 281 * MiB;
constexpr size_t WS_DT = 313 * MiB;
constexpr size_t WS_YPRE = 314 * MiB;
constexpr size_t WS_MIX = 442 * MiB;
constexpr size_t WS_SS = 314 * MiB;
constexpr size_t WS_GS = 346 * MiB;
constexpr size_t WS_SW = 417 * MiB;
constexpr size_t WS_SCD = 418 * MiB;
constexpr size_t WS_KD = 419 * MiB;
constexpr size_t WS_DKL = 435 * MiB;
constexpr size_t WS_CD = 410 * MiB;
constexpr size_t WS_GD = 410 * MiB + 65536;
constexpr size_t WS_H2 = 49 * MiB;
__host__ __device__ constexpr size_t w1_off(int e) { return (e < 24 ? (size_t)(233 + 2 * e) : (size_t)(17 + 2 * (e - 24))) * MiB; }
__host__ __device__ constexpr size_t w2_off(int e) { return (e < 16 ? (size_t)(33 + e) : e < 28 ? (size_t)(1 + (e - 16)) : (size_t)(411 + (e - 28))) * MiB; }
constexpr size_t WS_ACT = 65 * MiB;
constexpr size_t WS_SLAB = 281 * MiB;
constexpr size_t WS_LIST = 415 * MiB;
constexpr size_t WS_END = 506 * MiB;
constexpr int CW_BAR = 1024;
constexpr int CW_CVT = 6144;
constexpr int CW_CNT = 8192, CNT_STRIDE = 128;

constexpr int RING_BYTES = 131072;
constexpr int LDS_BYTES = 163840;
constexpr int TAB_OFF = LDS_BYTES - 1024;
constexpr int MISC_OFF = LDS_BYTES - 256;
constexpr int WR_STRIDE = 36;

typedef __bf16 bf16x2_t __attribute__((ext_vector_type(2)));
typedef float f32x2_t __attribute__((ext_vector_type(2)));
__device__ __forceinline__ unsigned pk2(float lo, float hi) { const f32x2_t v = {lo, hi}; return __builtin_bit_cast(unsigned, __builtin_convertvector(v, bf16x2_t)); }
__device__ __forceinline__ unsigned f2bf(float f) { return pk2(f, f) & 0xffffu; }
__device__ __forceinline__ float bf2f(unsigned b) { return __builtin_bit_cast(float, b << 16); }
__device__ __forceinline__ float bflo(unsigned w) { return __builtin_bit_cast(float, w << 16); }
__device__ __forceinline__ float bfhi(unsigned w) { return __builtin_bit_cast(float, w & 0xffff0000u); }
__device__ __forceinline__ unsigned pk4_fp8(float a, float b, float c, float d) { int p = __builtin_amdgcn_cvt_pk_fp8_f32(a, b, 0, false); p = __builtin_amdgcn_cvt_pk_fp8_f32(c, d, p, true); return (unsigned)p; }
__device__ __forceinline__ float wave_sum(float v) {
#pragma unroll
    for (int o = 1; o < 64; o <<= 1) v += __shfl_xor(v, o);
    return v;
}
__device__ __forceinline__ float silu_f(float x) { return x * __builtin_amdgcn_rcpf(1.f + __expf(-x)); }
__device__ __forceinline__ float softplus_f(float x) { return fmaxf(x, 0.f) + __logf(1.f + __expf(-fabsf(x))); }
__device__ __forceinline__ float logsigmoid_f(float x) { return fminf(x, 0.f) - __logf(1.f + __expf(-fabsf(x))); }

#define XB_TMO      128
#define XB_XCNT(j)  (256  + 64 * (j))
#define XB_XSUB(j)  (1280 + 64 * (j))
#define XB_XGEN(j)  (2304 + 64 * (j))
#define XB_TOP      3328
#define XB_TOPGEN   3392
#define XCD_BAR_WORDS 3456
#define XB_SPIN_CAP (1u << 21)
__device__ __forceinline__ unsigned xb_ld(unsigned* p)              { return __hip_atomic_load(p, __ATOMIC_RELAXED, __HIP_MEMORY_SCOPE_AGENT); }
__device__ __forceinline__ unsigned xb_add(unsigned* p, unsigned v) { return __hip_atomic_fetch_add(p, v, __ATOMIC_RELAXED, __HIP_MEMORY_SCOPE_AGENT); }
__device__ __forceinline__ unsigned xb_xcc_id() { return (unsigned)__builtin_amdgcn_s_getreg((3 << 11) | 20) & 0xFu; }
#define XB_SPIN(cond, bar) do { unsigned _sp = 0; while (cond) { __builtin_amdgcn_s_sleep(1); \
    if ((++_sp & 255u) == 0u) { if (xb_ld(&(bar)[XB_TMO])) break; if (_sp > XB_SPIN_CAP) { atomicAdd(&(bar)[XB_TMO], 1u); break; } } } } while (0)
struct XcdBarrier { unsigned* bar; unsigned x; volatile LAS unsigned* st; };
__device__ __forceinline__ XcdBarrier xcd_barrier_post(unsigned* bar, volatile LAS unsigned* st) {
    XcdBarrier b; b.bar = bar; b.x = xb_xcc_id(); b.st = st;
    if (threadIdx.x == 0) (void)xb_add(&bar[XB_XCNT(b.x)], 1u);
    return b;
}
__device__ __forceinline__ void xcd_barrier_complete(unsigned* bar, unsigned x, unsigned& nloc, unsigned& nx) {
    const unsigned G = gridDim.x * gridDim.y * gridDim.z;
    unsigned sum, cnt, mine, sp = 0u;
    for (;;) {
        sum = 0u; cnt = 0u; mine = 0u;
#pragma unroll
        for (unsigned j = 0; j < 16; ++j) { const unsigned c = xb_ld(&bar[XB_XCNT(j)]); sum += c; cnt += (c > 0u) ? 1u : 0u; mine = (j == x) ? c : mine; }
        if (sum == G) break;
        __builtin_amdgcn_s_sleep(1);
        if ((++sp & 255u) == 0u) { if (xb_ld(&bar[XB_TMO])) break; if (sp > XB_SPIN_CAP) { atomicAdd(&bar[XB_TMO], 1u); break; } }
    }
    nloc = mine > 0u ? mine : 1u; nx = cnt > 0u ? cnt : 1u;
}
__device__ __forceinline__ void xcd_barrier(const XcdBarrier& b) {
    asm volatile("s_waitcnt vmcnt(0)" ::: "memory");
    __syncthreads();
    if (threadIdx.x == 0) {
        unsigned* bar = b.bar;
        __builtin_amdgcn_s_waitcnt(0);
        unsigned nloc = b.st[0], nx = b.st[1];
        if (nloc == 0u) { xcd_barrier_complete(bar, b.x, nloc, nx); b.st[0] = nloc; b.st[1] = nx; }
        const unsigned old = xb_add(&bar[XB_XSUB(b.x)], 1u);
        const unsigned gen = old / nloc;
        if (old + 1u == (gen + 1u) * nloc) {
            __builtin_amdgcn_fence(__ATOMIC_RELEASE, "agent");
            asm volatile("s_waitcnt vmcnt(0)" ::: "memory");
            const unsigned og = xb_add(&bar[XB_TOP], 1u);
            const unsigned tg = og / nx;
            if (og + 1u == (tg + 1u) * nx) xb_add(&bar[XB_TOPGEN], 1u);
            else XB_SPIN(xb_ld(&bar[XB_TOPGEN]) == tg, bar);
            __builtin_amdgcn_fence(__ATOMIC_ACQUIRE, "agent");
            xb_add(&bar[XB_XGEN(b.x)], 1u);
            asm volatile("s_waitcnt vmcnt(0)" ::: "memory");
        } else {
            XB_SPIN(xb_ld(&bar[XB_XGEN(b.x)]) == gen, bar);
            __builtin_amdgcn_fence(__ATOMIC_ACQUIRE, "agent");
            asm volatile("s_waitcnt vmcnt(0)" ::: "memory");
        }
    }
    __syncthreads();
}

namespace pg8 {
constexpr int BM = 256, BK = 64, HALF = 128, HTB = HALF * BK * 2, STAGE_BYTES = 8 * HTB;
__device__ __forceinline__ int lds_byte(int r, int c) { const int st = (r >> 4) * 2 + (c >> 5), rr = r & 15, cc = c & 31, ob = rr * 64 + cc * 2; return st * 1024 + (ob ^ (((ob >> 9) & 1) << 5)); }
__device__ __forceinline__ void stage_rc(int b, int& R, int& C) { const int st = b / 1024, sb = b % 1024, swz = sb ^ (((sb >> 9) & 1) << 5); R = (st >> 1) * 16 + swz / 64; C = (st & 1) * 32 + (swz % 64) / 2; }
__device__ __forceinline__ int perm32(int rho) { const int n = rho >> 4, i = rho & 15; return 8 * (i >> 2) + 4 * n + (i & 3); }
struct Unit { int pm, pn, e, pos0, slot; };

__device__ __forceinline__ v8i cat8(bf16x8 lo, bf16x8 hi) { return __builtin_shufflevector(__builtin_bit_cast(v4i, lo), __builtin_bit_cast(v4i, hi), 0, 1, 2, 3, 4, 5, 6, 7); }
__device__ __forceinline__ unsigned cvt_pk_bf16(float lo, float hi) { return pk2(lo, hi); }

template <class Epi, class Sched, bool F8 = false, bool SP2 = true, bool ALIGN_EPI = true, int KREP = 1, int EPIREP = 1>
__device__ __forceinline__ void gemm_phase(LAS unsigned char* lds, const char* Abase, const int rp, const Sched& S, const Epi& E) {
    const int tid = threadIdx.x, wid = __builtin_amdgcn_readfirstlane(tid >> 6), lane = tid & 63, wr = wid >> 2, wc = wid & 3, fr = lane & 15, fq = lane >> 4;
    const int nt = rp / 128;
    int Rr[2], Cb[2]; unsigned voffB[2];
#pragma unroll
    for (int i = 0; i < 2; ++i) { int R, C; stage_rc(tid * 16 + i * 8192, R, C); Rr[i] = R; Cb[i] = C * 2; const int Rb = Epi::PERM ? ((R & ~31) + perm32(R & 31)) : R; voffB[i] = (unsigned)(Rb * rp + C * 2); }
    const size_t kstep = (size_t)(BK * 2);
    const size_t hstep = (size_t)HALF * rp;
    const unsigned ldsw = (unsigned)wid * 1024u;
    const int aoff = lds_byte(wr * 64 + fr, fq * 8), boff = lds_byte(wc * 32 + fr, fq * 8);
#define PG8_SA(b, h) (((b) * 2 + (h)) * HTB)
#define PG8_SB(b, h) ((4 + (b) * 2 + (h)) * HTB)
#define PG8_STAGE(bufoff, gbase, voff) do { _Pragma("unroll") for (int _i = 0; _i < 2; ++_i) \
        __builtin_amdgcn_global_load_lds((const unsigned*)((const char*)(gbase) + (voff)[_i]), (LAS unsigned*)(lds + (bufoff) + ldsw + _i * 8192), 16, 0, 0); } while (0)
#define PG8_LDA(dst, b, h) do { _Pragma("unroll") for (int m = 0; m < 4; ++m) _Pragma("unroll") for (int k = 0; k < 2; ++k) dst[m][k] = *(const LAS bf16x8*)(lds + PG8_SA(b, h) + aoff + m * 2048 + k * 1024); } while (0)
#define PG8_LDB(dst, b, h) do { _Pragma("unroll") for (int n = 0; n < 2; ++n) _Pragma("unroll") for (int k = 0; k < 2; ++k) dst[n][k] = *(const LAS bf16x8*)(lds + PG8_SB(b, h) + boff + n * 2048 + k * 1024); } while (0)
#define PG8_MMA(ai, bj, At, Bt) do { __builtin_amdgcn_s_setprio(1); _Pragma("unroll") for (int m = 0; m < 4; ++m) _Pragma("unroll") for (int n = 0; n < 2; ++n) { \
        if constexpr (F8) asm volatile("v_mfma_scale_f32_16x16x128_f8f6f4 %0, %1, %2, %0, %3, %4 op_sel_hi:[0,0,0]" : "+v"(acc[ai][bj][m][n]) : "v"(cat8(Bt[n][0], Bt[n][1])), "v"(cat8(At[m][0], At[m][1])), "v"(sc_w), "v"(sc_a)); \
        else { _Pragma("unroll") for (int k = 0; k < 2; ++k) acc[ai][bj][m][n] = __builtin_amdgcn_mfma_f32_16x16x32_bf16(Bt[n][k], At[m][k], acc[ai][bj][m][n], 0, 0, 0); } } \
        __builtin_amdgcn_s_setprio(0); } while (0)
#define PG8_WAIT_V(n) asm volatile("s_waitcnt vmcnt(" #n ")" ::: "memory")
#define PG8_WAIT_L(n) asm volatile("s_waitcnt lgkmcnt(" #n ")" ::: "memory")
#define PG8_BAR __builtin_amdgcn_s_barrier()
#define PG8_SCHED __builtin_amdgcn_sched_barrier(0)
    Unit cur, nxt; int ui = 0;
    if (!S.next(0, cur)) return;
    const int sc_w = Epi::SCALE_W, sc_a = 0x7f7f7f7f;
    f32x4 acc[2][2][4][2];
#pragma unroll
    for (int b = 0; b < 2; ++b)
#pragma unroll
        for (int n = 0; n < 2; ++n) { const f32x4 bi = E.bias(cur, b, n, wc, fq);
#pragma unroll
            for (int a = 0; a < 2; ++a)
#pragma unroll
                for (int m = 0; m < 4; ++m) acc[a][b][m][n] = bi; }
    bf16x8 At[4][2], B0[2][2], B1[2][2];
    unsigned ca[2][2];
    S.a_off(cur, Rr, Cb, ca);
    const char* cB = S.b_ptr(cur);
    if constexpr (SP2) {
        PG8_STAGE(PG8_SB(0, 0), cB, voffB); PG8_STAGE(PG8_SB(0, 1), cB + hstep, voffB); PG8_STAGE(PG8_SA(0, 0), Abase, ca[0]); PG8_STAGE(PG8_SA(0, 1), Abase, ca[1]);
        if (wr == 1) PG8_BAR;
        PG8_WAIT_V(2); PG8_BAR;
        PG8_STAGE(PG8_SB(1, 0), cB + kstep, voffB); PG8_STAGE(PG8_SA(1, 0), Abase + kstep, ca[0]); PG8_STAGE(PG8_SB(1, 1), cB + hstep + kstep, voffB);
        PG8_WAIT_V(6); PG8_BAR;
    } else {
        PG8_STAGE(PG8_SB(0, 0), cB, voffB); PG8_STAGE(PG8_SA(0, 0), Abase, ca[0]); PG8_STAGE(PG8_SB(0, 1), cB + hstep, voffB); PG8_STAGE(PG8_SA(0, 1), Abase, ca[1]);
        if (wr == 1) PG8_BAR;
        PG8_WAIT_V(4); PG8_BAR;
        PG8_STAGE(PG8_SB(1, 0), cB + kstep, voffB); PG8_STAGE(PG8_SA(1, 0), Abase + kstep, ca[0]); PG8_STAGE(PG8_SB(1, 1), cB + hstep + kstep, voffB);
        PG8_WAIT_V(6); PG8_BAR;
    }
    for (;;) {
        const bool has_next = S.next(ui + 1, nxt);
        const char* nB = has_next ? S.b_ptr(nxt) : cB;
        for (int t = 0; t < nt * KREP; t += 2) {
            const bool last = (t == nt * KREP - 2);
            const char* a1 = Abase + (size_t)((t + 1) & (nt - 1)) * kstep;
            const char* a2 = last ? Abase : Abase + (size_t)((t + 2) & (nt - 1)) * kstep; const char* b2 = last ? nB : cB + (size_t)((t + 2) & (nt - 1)) * kstep;
            const char* a3 = a2 + kstep; const char* b3 = b2 + kstep;
            unsigned o2[2][2];
#pragma unroll
            for (int h = 0; h < 2; ++h)
#pragma unroll
                for (int i = 0; i < 2; ++i) o2[h][i] = ca[h][i];
            if (last && has_next) S.a_off(nxt, Rr, Cb, o2);
            if constexpr (SP2) {
            PG8_LDB(B0, 0, 0); PG8_LDB(B1, 0, 1); PG8_SCHED; PG8_LDA(At, 0, 0); PG8_STAGE(PG8_SA(1, 1), a1, ca[1]);
            PG8_WAIT_V(8); PG8_WAIT_L(0); PG8_BAR; PG8_MMA(0, 0, At, B0); PG8_MMA(0, 1, At, B1); PG8_BAR; PG8_SCHED;
            PG8_LDA(At, 0, 1); PG8_STAGE(PG8_SB(0, 0), b2, voffB); PG8_STAGE(PG8_SB(0, 1), b2 + hstep, voffB); PG8_STAGE(PG8_SA(0, 0), a2, o2[0]);
            PG8_WAIT_V(8); PG8_WAIT_L(0); PG8_BAR; PG8_MMA(1, 0, At, B0); PG8_MMA(1, 1, At, B1); PG8_BAR; PG8_SCHED;
            PG8_LDB(B0, 1, 0); PG8_LDB(B1, 1, 1); PG8_SCHED; PG8_LDA(At, 1, 0); PG8_STAGE(PG8_SA(0, 1), a2, o2[1]);
            PG8_WAIT_V(8); PG8_WAIT_L(0); PG8_BAR; PG8_MMA(0, 0, At, B0); PG8_MMA(0, 1, At, B1); PG8_BAR; PG8_SCHED;
            PG8_LDA(At, 1, 1); PG8_STAGE(PG8_SB(1, 0), b3, voffB); PG8_STAGE(PG8_SB(1, 1), b3 + hstep, voffB); PG8_STAGE(PG8_SA(1, 0), a3, o2[0]);
            PG8_WAIT_V(8); PG8_WAIT_L(0); PG8_BAR; PG8_MMA(1, 0, At, B0); PG8_MMA(1, 1, At, B1); PG8_BAR; PG8_SCHED;
            } else {
            PG8_LDB(B0, 0, 0); PG8_SCHED; PG8_LDA(At, 0, 0); PG8_STAGE(PG8_SA(1, 1), a1, ca[1]);
            PG8_WAIT_L(8); PG8_BAR; PG8_WAIT_L(0); PG8_MMA(0, 0, At, B0); PG8_BAR; PG8_SCHED;
            PG8_LDB(B1, 0, 1); PG8_STAGE(PG8_SB(0, 0), b2, voffB);
            PG8_BAR; PG8_WAIT_L(0); PG8_MMA(0, 1, At, B1); PG8_BAR;
            PG8_LDA(At, 0, 1); PG8_STAGE(PG8_SA(0, 0), a2, o2[0]);
            PG8_BAR; PG8_WAIT_L(0); PG8_MMA(1, 0, At, B0); PG8_BAR; PG8_SCHED;
            PG8_STAGE(PG8_SB(0, 1), b2 + hstep, voffB);
            PG8_WAIT_V(6); PG8_BAR; PG8_MMA(1, 1, At, B1); PG8_BAR;
            PG8_LDB(B0, 1, 0); PG8_SCHED; PG8_LDA(At, 1, 0); PG8_STAGE(PG8_SA(0, 1), a2, o2[1]);
            PG8_WAIT_L(8); PG8_BAR; PG8_WAIT_L(0); PG8_MMA(0, 0, At, B0); PG8_BAR; PG8_SCHED;
            PG8_LDB(B1, 1, 1); PG8_STAGE(PG8_SB(1, 0), b3, voffB);
            PG8_BAR; PG8_WAIT_L(0); PG8_MMA(0, 1, At, B1); PG8_BAR;
            PG8_LDA(At, 1, 1); PG8_STAGE(PG8_SA(1, 0), a3, o2[0]);
            PG8_BAR; PG8_WAIT_L(0); PG8_MMA(1, 0, At, B0); PG8_BAR; PG8_SCHED;
            PG8_STAGE(PG8_SB(1, 1), b3 + hstep, voffB);
            PG8_WAIT_V(6); PG8_BAR; PG8_MMA(1, 1, At, B1); PG8_BAR;
            }
        }
        if constexpr (ALIGN_EPI) { if (wr == 0) PG8_BAR; }
        if constexpr (F8) asm volatile("s_nop 15\n\ts_nop 15" ::: "memory");
        if constexpr (KREP > 1) {
#pragma unroll
            for (int a = 0; a < 2; ++a)
#pragma unroll
                for (int b = 0; b < 2; ++b)
#pragma unroll
                    for (int m = 0; m < 4; ++m)
#pragma unroll
                        for (int n = 0; n < 2; ++n) acc[a][b][m][n] *= (1.f / KREP);
        }
#pragma unroll 1
        for (int er = 0; er < EPIREP; ++er) { E(acc, cur, wr, wc, fr, fq); asm volatile("" ::: "memory"); }
        if (!has_next) break;
#pragma unroll
        for (int b = 0; b < 2; ++b)
#pragma unroll
            for (int n = 0; n < 2; ++n) { const f32x4 bi = E.bias(nxt, b, n, wc, fq);
#pragma unroll
                for (int a = 0; a < 2; ++a)
#pragma unroll
                    for (int m = 0; m < 4; ++m) acc[a][b][m][n] = bi; }
        cur = nxt; cB = nB; ++ui;
        if constexpr (ALIGN_EPI) { if (wr == 1) PG8_BAR; }
        S.a_off(cur, Rr, Cb, ca);
    }
    PG8_WAIT_V(0);
    if constexpr (!ALIGN_EPI) { if (wr == 0) PG8_BAR; }
    PG8_BAR;
#undef PG8_SA
#undef PG8_SB
#undef PG8_STAGE
#undef PG8_LDA
#undef PG8_LDB
#undef PG8_MMA
#undef PG8_WAIT_V
#undef PG8_WAIT_L
#undef PG8_BAR
#undef PG8_SCHED
}
}

struct DenseSched {
    static constexpr bool GATHER = false;
    int nM, nN, G, vcu, pitch; const char* Bt;
    __device__ __forceinline__ bool next(int i, pg8::Unit& u) const {
        const int L = i * G + vcu; if (L >= nM * nN) return false;
        const int nig = 8 * nN, gid = L / nig, r = L % nig, fm = gid * 8, gsz = (nM - fm) < 8 ? (nM - fm) : 8;
        u.pm = fm + r % gsz; u.pn = r / gsz; u.e = 0; u.pos0 = 0; u.slot = i; return true;
    }
    __device__ __forceinline__ void a_off(const pg8::Unit& u, const int (&R)[2], const int (&Cb)[2], unsigned (&off)[2][2]) const {
#pragma unroll
        for (int h = 0; h < 2; ++h)
#pragma unroll
            for (int i = 0; i < 2; ++i) off[h][i] = (unsigned)((u.pm * 256 + h * 128 + R[i]) * pitch) + (unsigned)Cb[i];
    }
    __device__ __forceinline__ const char* b_ptr(const pg8::Unit& u) const { return Bt + (size_t)u.pn * 256 * pitch; }
};
template <bool GATHER_> struct MoeSched {
    static constexpr bool GATHER = GATHER_;
    int nN, G, vcu, pitch, ntiles; const LAS int* cnt; const LAS int* tstart; const LAS int* toks; const char* wsb; int which;
    __device__ __forceinline__ bool next(int i, pg8::Unit& u) const {
        const int L = i * G + vcu; if (L >= ntiles * nN) return false;
        const int pm = L / nN; int e = 0;
        for (int j = 1; j < NE; ++j) e += (tstart[j] <= pm) ? 1 : 0;
        u.pm = __builtin_amdgcn_readfirstlane(pm); u.pn = __builtin_amdgcn_readfirstlane(L % nN); u.e = __builtin_amdgcn_readfirstlane(e);
        u.pos0 = __builtin_amdgcn_readfirstlane((pm - tstart[e]) * 256); u.slot = i; return true;
    }
    __device__ __forceinline__ void a_off(const pg8::Unit& u, const int (&R)[2], const int (&Cb)[2], unsigned (&off)[2][2]) const {
#pragma unroll
        for (int h = 0; h < 2; ++h)
#pragma unroll
            for (int i = 0; i < 2; ++i) {
                if (GATHER) off[h][i] = (unsigned)toks[u.slot * 256 + h * 128 + R[i]] * (unsigned)pitch + (unsigned)Cb[i];
                else off[h][i] = (unsigned)((u.pm * 256 + h * 128 + R[i]) * pitch) + (unsigned)Cb[i];
            }
    }
    __device__ __forceinline__ const char* b_ptr(const pg8::Unit& u) const { return wsb + (which == 1 ? w1_off(u.e) : w2_off(u.e)) + (size_t)u.pn * 256 * pitch; }
};
__device__ __forceinline__ void moe_tokens(LAS int* toks, int nN, int G, int vcu, int ntiles, const LAS int* cnt, const LAS int* tstart, const unsigned* list, int tid) {
    for (int i = 0; i < 12; ++i) { const int L = i * G + vcu; if (L >= ntiles * nN) break;
        const int pm = L / nN; int e = 0;
        for (int j = 1; j < NE; ++j) e += (tstart[j] <= pm) ? 1 : 0;
        const int pos = (pm - tstart[e]) * 256 + tid;
        if (tid < 256) toks[i * 256 + tid] = (pos < cnt[e]) ? (int)((list[e * LCAP + pos] & 0xffffu) >> 2) : 0; }
    __syncthreads();
}

constexpr int EPT_OFF = RING_BYTES + 4096 + 12288;
__device__ __forceinline__ void moe_epi_gateup(LAS float* tab, int nN, int G, int vcu, int ntiles, const LAS int* tstart, const float* bg, const float* bu, int tid) {
    for (int i = 0; i < 12; ++i) { const int L = i * G + vcu; if (L >= ntiles * nN) break;
        const int pm = L / nN, pn = L % nN; int e = 0;
        for (int j = 1; j < NE; ++j) e += (tstart[j] <= pm) ? 1 : 0;
        if (tid < 256) { const int j = tid & 127; tab[i * 256 + tid] = (tid < 128) ? bg[e * 1024 + pn * 128 + j] : bu[e * 1024 + pn * 128 + j] + 1.f; } }
    __syncthreads();
}
__device__ __forceinline__ void moe_epi_down(LAS unsigned* tab, int nN, int G, int vcu, int ntiles, const LAS int* cnt, const LAS int* tstart, const unsigned* list, const float* bd, int tid) {
    for (int i = 0; i < 6; ++i) { const int L = i * G + vcu; if (L >= ntiles * nN) break;
        const int pm = L / nN, pn = L % nN; int e = 0;
        for (int j = 1; j < NE; ++j) e += (tstart[j] <= pm) ? 1 : 0;
        const int pos = (pm - tstart[e]) * 256 + tid;
        if (tid < 256) tab[i * 512 + tid] = (pos < cnt[e]) ? list[e * LCAP + pos] : 0xffffffffu;
        else tab[i * 512 + tid] = __builtin_bit_cast(unsigned, bd[e * 1024 + pn * 256 + tid - 256]); }
    __syncthreads();
}
struct EpiProj {
    static constexpr bool PERM = true; static constexpr int SCALE_W = 0x7f7f7f7f;
    bf16* O;
    __device__ __forceinline__ f32x4 bias(const pg8::Unit&, int, int, int, int) const { return (f32x4){0.f, 0.f, 0.f, 0.f}; }
    __device__ __forceinline__ void operator()(const f32x4 (&acc)[2][2][4][2], const pg8::Unit& u, int wr, int wc, int fr, int fq) const {
        const int row0 = u.pm * 256 + wr * 64 + fr, col0 = u.pn * 256 + wc * 32 + 8 * fq;
#pragma unroll
        for (int ai = 0; ai < 2; ++ai)
#pragma unroll
            for (int m = 0; m < 4; ++m) { bf16* rowp = O + (size_t)(row0 + ai * 128 + m * 16) * NIN + col0;
#pragma unroll
                for (int bj = 0; bj < 2; ++bj) { const f32x4 v0 = acc[ai][bj][m][0], v1 = acc[ai][bj][m][1];
                    v4u w; w.x = pg8::cvt_pk_bf16(v0[0], v0[1]); w.y = pg8::cvt_pk_bf16(v0[2], v0[3]); w.z = pg8::cvt_pk_bf16(v1[0], v1[1]); w.w = pg8::cvt_pk_bf16(v1[2], v1[3]);
                    *(v4u*)(rowp + bj * 128) = w; } }
    }
};
struct EpiRes {
    static constexpr bool PERM = false; static constexpr int SCALE_W = 0x7f7f7f7f;
    const float* x; float* out; const float* mod;
    __device__ __forceinline__ f32x4 bias(const pg8::Unit&, int, int, int, int) const { return (f32x4){0.f, 0.f, 0.f, 0.f}; }
    __device__ __forceinline__ void operator()(const f32x4 (&acc)[2][2][4][2], const pg8::Unit& u, int wr, int wc, int fr, int fq) const {
        const int row0 = u.pm * 256 + wr * 64 + fr, col0 = u.pn * 256 + wc * 32 + 4 * fq;
        const int b = (u.pm * 256) / SEQ;
        f32x4 gv[2][2];
#pragma unroll
        for (int bj = 0; bj < 2; ++bj)
#pragma unroll
            for (int n = 0; n < 2; ++n) gv[bj][n] = *(const f32x4*)(mod + b * 6144 + 2048 + col0 + bj * 128 + n * 16);
#pragma unroll
        for (int ai = 0; ai < 2; ++ai)
#pragma unroll
            for (int m = 0; m < 4; ++m) { const size_t off = (size_t)(row0 + ai * 128 + m * 16) * D + col0;
#pragma unroll
                for (int bj = 0; bj < 2; ++bj)
#pragma unroll
                    for (int n = 0; n < 2; ++n) { const f32x4 xv = *(const f32x4*)(x + off + bj * 128 + n * 16); *(f32x4*)(out + off + bj * 128 + n * 16) = xv + gv[bj][n] * acc[ai][bj][m][n]; } }
    }
};
struct EpiGateUp {
    static constexpr bool PERM = true; static constexpr int SCALE_W = 0x7a7a7a7a;
    bf16* act; const LAS float* tab;
    __device__ __forceinline__ f32x4 bias(const pg8::Unit& u, int bj, int n, int wc, int fq) const { return *(const LAS f32x4*)(tab + u.slot * 256 + 128 * bj + wc * 32 + 8 * fq + 4 * n); }
    __device__ __forceinline__ void operator()(const f32x4 (&acc)[2][2][4][2], const pg8::Unit& u, int wr, int wc, int fr, int fq) const {
        const int row0 = u.pm * 256 + wr * 64 + fr, c0 = u.pn * 128 + wc * 32 + 8 * fq;
#pragma unroll
        for (int ai = 0; ai < 2; ++ai)
#pragma unroll
            for (int m = 0; m < 4; ++m) { float o[8];
#pragma unroll
                for (int n = 0; n < 2; ++n) { const f32x4 g4 = acc[ai][0][m][n], u4 = acc[ai][1][m][n];
#pragma unroll
                    for (int jp = 0; jp < 2; ++jp) {
                        f32x2_t g2 = {fminf(g4[2 * jp], 7.f), fminf(g4[2 * jp + 1], 7.f)};
                        const f32x2_t u2 = {__builtin_amdgcn_fmed3f(u4[2 * jp], -6.f, 8.f), __builtin_amdgcn_fmed3f(u4[2 * jp + 1], -6.f, 8.f)};
                        const f32x2_t t2 = g2 * (-1.702f * 1.44269504f);
                        f32x2_t d2 = {__builtin_amdgcn_exp2f(t2.x), __builtin_amdgcn_exp2f(t2.y)}; d2 = d2 + 1.f;
                        const f32x2_t r2 = {__builtin_amdgcn_rcpf(d2.x), __builtin_amdgcn_rcpf(d2.y)};
                        const f32x2_t o2 = (g2 * r2) * u2; o[4 * n + 2 * jp] = o2.x; o[4 * n + 2 * jp + 1] = o2.y; } }
                if (MOE_FP8) *(v2u*)((unsigned char*)act + (size_t)(row0 + ai * 128 + m * 16) * 1024 + c0) = (v2u){pk4_fp8(o[0], o[1], o[2], o[3]), pk4_fp8(o[4], o[5], o[6], o[7])};
                else *(v4u*)(act + (size_t)(row0 + ai * 128 + m * 16) * 1024 + c0) = (v4u){pg8::cvt_pk_bf16(o[0], o[1]), pg8::cvt_pk_bf16(o[2], o[3]), pg8::cvt_pk_bf16(o[4], o[5]), pg8::cvt_pk_bf16(o[6], o[7])}; }
    }
};
struct EpiDown {
    static constexpr bool PERM = true; static constexpr int SCALE_W = 0x7a7a7a7a;
    bf16* slab; const LAS unsigned* tab;
    __device__ __forceinline__ f32x4 bias(const pg8::Unit& u, int bj, int n, int wc, int fq) const { return *(const LAS f32x4*)((const LAS float*)tab + u.slot * 512 + 256 + wc * 32 + 8 * fq + bj * 128 + 4 * n); }
    __device__ __forceinline__ void operator()(const f32x4 (&acc)[2][2][4][2], const pg8::Unit& u, int wr, int wc, int fr, int fq) const {
        const int r0 = wr * 64 + fr, col0 = u.pn * 256 + wc * 32 + 8 * fq;
        unsigned info[2][4];
#pragma unroll
        for (int ai = 0; ai < 2; ++ai)
#pragma unroll
            for (int m = 0; m < 4; ++m) info[ai][m] = tab[u.slot * 512 + r0 + ai * 128 + m * 16];
#pragma unroll
        for (int ai = 0; ai < 2; ++ai)
#pragma unroll
            for (int m = 0; m < 4; ++m) {
                if (info[ai][m] != 0xffffffffu) { const float w = (float)__builtin_bit_cast(_Float16, (unsigned short)(info[ai][m] >> 16)); bf16* rowp = slab + (size_t)(info[ai][m] & 0xffffu) * 1024 + col0;
#pragma unroll
                    for (int bj = 0; bj < 2; ++bj) {
                        if (SLAB_FP8) { const float w32 = w * 32.f; f32x4 v0 = acc[ai][bj][m][0] * w32, v1 = acc[ai][bj][m][1] * w32;
#pragma unroll
                            for (int q = 0; q < 4; ++q) { v0[q] = __builtin_amdgcn_fmed3f(v0[q], -448.f, 448.f); v1[q] = __builtin_amdgcn_fmed3f(v1[q], -448.f, 448.f); }
                            *(v2u*)((unsigned char*)slab + (size_t)(info[ai][m] & 0xffffu) * 1024 + col0 + bj * 128) = (v2u){pk4_fp8(v0[0], v0[1], v0[2], v0[3]), pk4_fp8(v1[0], v1[1], v1[2], v1[3])}; }
                        else { const f32x4 v0 = acc[ai][bj][m][0] * w, v1 = acc[ai][bj][m][1] * w;
                            v4u o; o.x = pg8::cvt_pk_bf16(v0[0], v0[1]); o.y = pg8::cvt_pk_bf16(v0[2], v0[3]); o.z = pg8::cvt_pk_bf16(v1[0], v1[1]); o.w = pg8::cvt_pk_bf16(v1[2], v1[3]);
                            *(v4u*)(rowp + bj * 128) = o; } } } }
    }
};

struct Args { const float* in[26]; float* out; unsigned char* ws; int ph_lo, ph_hi; };
struct Frame { LAS unsigned char* lds; int tid, lane, wave, vcu, G; };

template <class RowMap>
__device__ __forceinline__ void transpose_item(const float* W, int K, int N, bf16* WT, int item, int lane, const RowMap& rm) {
    const int nblk = N / 32, kb = item / nblk, nb = item % nblk, k0 = 64 * kb, n0 = 32 * nb, fr = lane & 15, fq = lane >> 4;
    float v[2][2][8];
#pragma unroll
    for (int kh = 0; kh < 2; ++kh)
#pragma unroll
        for (int j = 0; j < 8; ++j)
#pragma unroll
            for (int nt = 0; nt < 2; ++nt) v[kh][nt][j] = W[(size_t)(k0 + 32 * kh + 8 * fq + j) * N + n0 + 16 * nt + fr];
#pragma unroll
    for (int nt = 0; nt < 2; ++nt) { bf16* orow = WT + (size_t)rm(n0 + 16 * nt + fr) * K + k0 + 8 * fq;
#pragma unroll
        for (int kh = 0; kh < 2; ++kh) *(GAS v4u*)(orow + 32 * kh) = (v4u){pk2(v[kh][nt][0], v[kh][nt][1]), pk2(v[kh][nt][2], v[kh][nt][3]), pk2(v[kh][nt][4], v[kh][nt][5]), pk2(v[kh][nt][6], v[kh][nt][7])}; }
}
template <class RowMap>
__device__ __forceinline__ void transpose_item_f8(const float* W, int K, int N, unsigned char* WT, int item, int lane, const RowMap& rm) {
    const int nblk = N / 32, kb = item / nblk, nb = item % nblk, k0 = 64 * kb, n0 = 32 * nb, fr = lane & 15, fq = lane >> 4;
    float v[2][2][8];
#pragma unroll
    for (int kh = 0; kh < 2; ++kh)
#pragma unroll
        for (int j = 0; j < 8; ++j)
#pragma unroll
            for (int nt = 0; nt < 2; ++nt) v[kh][nt][j] = 32.f * W[(size_t)(k0 + 32 * kh + 8 * fq + j) * N + n0 + 16 * nt + fr];
#pragma unroll
    for (int nt = 0; nt < 2; ++nt) { unsigned char* orow = WT + (size_t)rm(n0 + 16 * nt + fr) * K + k0 + 8 * fq;
#pragma unroll
        for (int kh = 0; kh < 2; ++kh) *(GAS v2u*)(orow + 32 * kh) = (v2u){pk4_fp8(v[kh][nt][0], v[kh][nt][1], v[kh][nt][2], v[kh][nt][3]), pk4_fp8(v[kh][nt][4], v[kh][nt][5], v[kh][nt][6], v[kh][nt][7])}; }
}
struct MapWin { __device__ __forceinline__ int operator()(int n) const { if (n < 2560) return n; if (n < 2576) return PDT + (n - 2560); if (n < 4624) return n - 16; if (n < 4640) return PGL + (n - 4624); return n - 32; } };
struct MapId { __device__ __forceinline__ int operator()(int n) const { return n; } };
struct MapGU { int half; __device__ __forceinline__ int operator()(int c) const { return 256 * (c >> 7) + 128 * half + (c & 127); } };

__device__ __forceinline__ void phase0(const Args& a, Frame& F) {
    const float* c = a.in[1]; const float* w_ada = a.in[2]; const float* b_ada = a.in[3];
    float* mod = (float*)(a.ws + WS_MOD);
    if (F.vcu < 192) {
        LAS float* cond = (LAS float*)(F.lds + 98304);
        LAS float* part = (LAS float*)(F.lds + 98304 + 16384);
        for (int i = F.tid; i < 4096; i += 512) cond[i] = silu_f(c[i]);
        __syncthreads();
        const int col0 = 32 * F.vcu, rsub = F.lane >> 3, c4 = F.lane & 7;
        f32x4 acc[4];
#pragma unroll
        for (int b = 0; b < 4; ++b) acc[b] = (f32x4){0.f, 0.f, 0.f, 0.f};
#pragma unroll 4
        for (int it = 0; it < 16; ++it) { const int k = 128 * F.wave + 8 * it + rsub; const f32x4 wv = *(const f32x4*)(w_ada + (size_t)k * 6144 + col0 + 4 * c4);
#pragma unroll
            for (int b = 0; b < 4; ++b) acc[b] += wv * cond[b * 1024 + k]; }
#pragma unroll
        for (int b = 0; b < 4; ++b)
#pragma unroll
            for (int j = 0; j < 4; ++j) { float v = acc[b][j]; v += __shfl_xor(v, 8); v += __shfl_xor(v, 16); v += __shfl_xor(v, 32); acc[b][j] = v; }
        if (rsub == 0) {
#pragma unroll
            for (int b = 0; b < 4; ++b)
#pragma unroll
                for (int j = 0; j < 4; ++j) part[(F.wave * 4 + b) * 32 + 4 * c4 + j] = acc[b][j]; }
        __syncthreads();
        if (F.tid < 128) { const int b = F.tid >> 5, cc = F.tid & 31; float s = b_ada[col0 + cc];
#pragma unroll
            for (int w = 0; w < 8; ++w) s += part[(w * 4 + b) * 32 + cc];
            mod[b * 6144 + col0 + cc] = s; }
        __syncthreads();
    }
    const int gw = F.vcu * 8 + F.wave, NGW = F.G * 8;
    bf16* WinT = (bf16*)(a.ws + WS_WIN); bf16* WoutT = (bf16*)(a.ws + WS_WOUT);
    constexpr int I_IN = 16 * 177, I_OUT = 32 * 32;
    for (int it = gw; it < I_IN + I_OUT; it += NGW) {
        if (it < I_IN) transpose_item(a.in[5], 1024, 5664, WinT, it, F.lane, MapWin());
        else transpose_item(a.in[15], 2048, 1024, WoutT, it - I_IN, F.lane, MapId());
    }
    for (int i = F.vcu * 512 + F.tid; i < 224 * 1024 / 8; i += F.G * 512) *(v4u*)(WinT + (size_t)5664 * 1024 + (size_t)i * 8) = (v4u){0u, 0u, 0u, 0u};
}
__device__ __forceinline__ void phase1(const Args& a, Frame& F) {
    const float* x = a.in[0]; const float* g1 = a.in[4]; const float* mod = (const float*)(a.ws + WS_MOD); bf16* H = (bf16*)(a.ws + WS_H);
    const int gw = F.vcu * 8 + F.wave, NGW = F.G * 8;
    f32x4 Gm[4], Sh[4], nx[4]; int bprev = -1;
    if (gw < T) {
#pragma unroll
        for (int j = 0; j < 4; ++j) nx[j] = ((const f32x4*)(x + (size_t)gw * D) + F.lane)[64 * j]; }
    for (int m = gw; m < T; m += NGW) {
        const int b = m / SEQ;
        f32x4 v[4]; float s = 0.f;
#pragma unroll
        for (int j = 0; j < 4; ++j) { v[j] = nx[j]; s += (v[j].x * v[j].x + v[j].y * v[j].y) + (v[j].z * v[j].z + v[j].w * v[j].w); }
        if (m + NGW < T) {
#pragma unroll
            for (int j = 0; j < 4; ++j) nx[j] = ((const f32x4*)(x + (size_t)(m + NGW) * D) + F.lane)[64 * j]; }
        if (b != bprev) { bprev = b;
#pragma unroll
            for (int j = 0; j < 4; ++j) { const int d0 = 4 * F.lane + 256 * j; Gm[j] = *(const f32x4*)(g1 + d0) * (*(const f32x4*)(mod + b * 6144 + 1024 + d0) + 1.f); Sh[j] = *(const f32x4*)(mod + b * 6144 + d0); } }
        const float rstd = 1.f / sqrtf(wave_sum(s) * (1.f / D) + EPS);
        v2u* o8 = (v2u*)(H + (size_t)m * D) + F.lane;
#pragma unroll
        for (int j = 0; j < 4; ++j) { const f32x4 h = v[j] * rstd * Gm[j] + Sh[j]; v2u w; w.x = pk2(h.x, h.y); w.y = pk2(h.z, h.w); o8[64 * j] = w; }
    }
}
__device__ __forceinline__ void phase3(const Args& a, Frame& F) {
    const bf16* P = (const bf16*)(a.ws + WS_PROJ); bf16* XA = (bf16*)a.out; float* GK = (float*)(a.ws + WS_GK); float* DT = (float*)(a.ws + WS_DT); bf16* KD = (bf16*)(a.ws + WS_KD); float* DKL = (float*)(a.ws + WS_DKL);
    const float* cw = a.in[6]; const float* cb = a.in[7]; const float* dtb = a.in[8]; const float* wg2 = a.in[12]; const float* bgl = a.in[13];
    const int gt = F.vcu * 512 + F.tid, NT = F.G * 512;
    for (int cidx = F.vcu; cidx < T / 64; cidx += F.G) {
        const int t0 = cidx * 64, k = F.tid; LAS v4u* gl = (LAS v4u*)F.lds;
        LAS float* lrun = (LAS float*)(F.lds + 4096);
        __syncthreads();
        if (F.tid < 128) gl[F.tid] = *(const v4u*)(P + (size_t)(t0 + (F.tid >> 1)) * NIN + PGL + 8 * (F.tid & 1));
        v4u kk8[8];
#pragma unroll
        for (int i = 0; i < 8; ++i) kk8[i] = *(const v4u*)(P + (size_t)(t0 + (F.tid >> 6) + 8 * i) * NIN + PK + 8 * (F.tid & 63));
        float wv[16];
#pragma unroll
        for (int r = 0; r < 16; ++r) wv[r] = wg2[r * 512 + k];
        const float bias = bgl[k]; float run = 0.f;
        __syncthreads();
#pragma unroll 4
        for (int l = 0; l < 64; ++l) {
            const v4u g0 = gl[2 * l], g1 = gl[2 * l + 1]; const unsigned gw[8] = {g0.x, g0.y, g0.z, g0.w, g1.x, g1.y, g1.z, g1.w};
            float s = bias;
#pragma unroll
            for (int r = 0; r < 8; ++r) { s += bflo(gw[r]) * wv[2 * r]; s += bfhi(gw[r]) * wv[2 * r + 1]; }
            run += logsigmoid_f(s) * (1.f / 16.f); GK[(size_t)(t0 + l) * 512 + k] = run; lrun[l * 512 + k] = run; }
        DKL[(size_t)cidx * 512 + k] = __expf(run);
        __syncthreads();
#pragma unroll
        for (int i = 0; i < 8; ++i) { const int l = (F.tid >> 6) + 8 * i, k0 = 8 * (F.tid & 63);
            const v4u kk = kk8[i];
            const f32x4 l0 = *(const LAS f32x4*)(lrun + 63 * 512 + k0), l1 = *(const LAS f32x4*)(lrun + 63 * 512 + k0 + 4), c0 = *(const LAS f32x4*)(lrun + l * 512 + k0), c1 = *(const LAS f32x4*)(lrun + l * 512 + k0 + 4);
            const float bl[8] = {l0.x, l0.y, l0.z, l0.w, l1.x, l1.y, l1.z, l1.w}, bc[8] = {c0.x, c0.y, c0.z, c0.w, c1.x, c1.y, c1.z, c1.w}; const unsigned kw[4] = {kk.x, kk.y, kk.z, kk.w}; unsigned ko[4];
#pragma unroll
            for (int j = 0; j < 4; ++j) ko[j] = pk2(bflo(kw[j]) * __expf(bl[2 * j] - bc[2 * j]), bfhi(kw[j]) * __expf(bl[2 * j + 1] - bc[2 * j + 1]));
            *(v4u*)(KD + (size_t)(t0 + l) * 512 + k0) = (v4u){ko[0], ko[1], ko[2], ko[3]}; }
    }
    { float* SW = (float*)(a.ws + WS_SW); float* SCD = (float*)(a.ws + WS_SCD); const float* a_log = a.in[9];
      for (int u = F.vcu * 8 + F.wave; u < NB * 32 * 16; u += F.G * 8) { const int h = u & 15, bc = u >> 4, t0 = bc * 128, i = F.lane;
        const float av = -__expf(a_log[h]);
        const float d0 = softplus_f(bf2f(P[(size_t)(t0 + 2 * i) * NIN + PDT + h]) + dtb[h]), d1 = softplus_f(bf2f(P[(size_t)(t0 + 2 * i + 1) * NIN + PDT + h]) + dtb[h]);
        DT[(size_t)(t0 + 2 * i) * 16 + h] = d0; DT[(size_t)(t0 + 2 * i + 1) * 16 + h] = d1;
        const float a0 = d0 * av, a1 = d1 * av; float s = a0 + a1;
#pragma unroll
        for (int o = 1; o < 64; o <<= 1) { const float t = __shfl_up(s, o); if (i >= o) s += t; }
        const float cend = __shfl(s, 63);
        SW[(size_t)(t0 + 2 * i) * 16 + h] = d0 * __expf(cend - (s - a1)); SW[(size_t)(t0 + 2 * i + 1) * 16 + h] = d1 * __expf(cend - s);
        if (i == 63) SCD[u] = __expf(cend); } }
    { const int cq = gt % 192, tb0 = gt / 192, c0 = cq * 8; const int TBS = NT / 192; constexpr int NTB = T / 8;
      if (tb0 < TBS) {
        f32x4 wl[4][2];
#pragma unroll
        for (int r = 0; r < 4; ++r) { wl[r][0] = *(const f32x4*)(cw + r * 1536 + c0); wl[r][1] = *(const f32x4*)(cw + r * 1536 + c0 + 4); }
        const f32x4 b0 = *(const f32x4*)(cb + c0), b1 = *(const f32x4*)(cb + c0 + 4);
        v4u rows[11], nrows[11];
        auto ld_rows = [&](int tb, v4u (&rw)[11]) { const int t0 = tb * 8; const bool first = (t0 % SEQ) == 0;
#pragma unroll
            for (int rr = 0; rr < 11; ++rr) { if (rr < 3 && first) rw[rr] = (v4u){0u, 0u, 0u, 0u}; else rw[rr] = *(const v4u*)(P + (size_t)(t0 - 3 + rr) * NIN + PX + c0); } };
        ld_rows(tb0, rows);
        for (int tb = tb0; tb < NTB; tb += TBS) { const int t0 = tb * 8;
            if (tb + TBS < NTB) ld_rows(tb + TBS, nrows);
#pragma unroll
            for (int tt = 0; tt < 8; ++tt) { f32x4 o0 = b0, o1 = b1;
#pragma unroll
                for (int r = 0; r < 4; ++r) { const v4u pv = rows[tt + r];
                    o0 += wl[r][0] * (f32x4){bflo(pv.x), bfhi(pv.x), bflo(pv.y), bfhi(pv.y)}; o1 += wl[r][1] * (f32x4){bflo(pv.z), bfhi(pv.z), bflo(pv.w), bfhi(pv.w)}; }
                *(v4u*)(XA + (size_t)(t0 + tt) * 1536 + c0) = (v4u){pk2(silu_f(o0.x), silu_f(o0.y)), pk2(silu_f(o0.z), silu_f(o0.w)), pk2(silu_f(o1.x), silu_f(o1.y)), pk2(silu_f(o1.z), silu_f(o1.w))}; }
#pragma unroll
            for (int rr = 0; rr < 11; ++rr) rows[rr] = nrows[rr];
        } } }
}
typedef LAS unsigned char* ldsp;
#define MFMA16(a, b, c) __builtin_amdgcn_mfma_f32_16x16x32_bf16(a, b, c, 0, 0, 0)
__device__ __forceinline__ bf16x8 ldfrag(ldsp base, int row, int stride, int kel) { return *(const LAS bf16x8*)(base + row * stride + kel * 2); }
constexpr float QSCALE = 0.08838834764831845f;

__device__ __forceinline__ void ssd_dtcs(const Args& a, Frame& F, int b, int c, int g, LAS float* dtv, LAS float* csv, float* cd_out) {
    const float* DT = (const float*)(a.ws + WS_DT); const int t0 = b * SEQ + c * 128, hh = F.wave, h = g * 8 + hh, i = F.lane;
    const float av = -__expf(a.in[9][h]);
    const float d0 = DT[(size_t)(t0 + 2 * i) * 16 + h], d1 = DT[(size_t)(t0 + 2 * i + 1) * 16 + h];
    const float a0 = d0 * av, a1 = d1 * av; float s = a0 + a1;
#pragma unroll
    for (int o = 1; o < 64; o <<= 1) { const float t = __shfl_up(s, o); if (i >= o) s += t; }
    dtv[hh * 128 + 2 * i] = d0; dtv[hh * 128 + 2 * i + 1] = d1; csv[hh * 128 + 2 * i] = s - a1; csv[hh * 128 + 2 * i + 1] = s;
    if (cd_out != nullptr && i == 63) cd_out[(b * 32 + c) * 16 + h] = __expf(s);
}
__device__ __forceinline__ void p4a_ssd(const Args& a, Frame& F, int item) {
    const int b = item >> 6, c = (item >> 1) & 31, g = item & 1, t0 = b * SEQ + c * 128;
    const bf16* XA = (const bf16*)a.out; bf16* SS = (bf16*)(a.ws + WS_SS);
    ldsp BT = F.lds, xwT = F.lds + 34816; LAS float* dtv = (LAS float*)(F.lds + 52224); LAS float* csv = dtv + 1024;
    const int w = F.wave, fr = F.lane & 15, fq = F.lane >> 4;
    ssd_dtcs(a, F, b, c, g, dtv, csv, (float*)(a.ws + WS_CD));
#pragma unroll
    for (int q = 0; q < 4; ++q) { const int idx = F.tid + 512 * q, n = idx & 127, lc = idx >> 7; const bf16* xb = XA + (size_t)t0 * 1536; const unsigned off = (unsigned)(8 * lc * 1536 + 1024 + g * 128 + n);
        unsigned e[8];
#pragma unroll
        for (int j = 0; j < 8; ++j) e[j] = (xb + j * 1536)[off];
        *(LAS v4u*)(BT + n * 272 + lc * 16) = (v4u){e[0] | (e[1] << 16), e[2] | (e[3] << 16), e[4] | (e[5] << 16), e[6] | (e[7] << 16)}; }
    __syncthreads();
    bf16x8 Bf[4];
#pragma unroll
    for (int ks = 0; ks < 4; ++ks) Bf[ks] = ldfrag(BT, 16 * w + fr, 272, 32 * ks + 8 * fq);
    for (int hh = 0; hh < 8; ++hh) {
        const int h = g * 8 + hh; const float cend = csv[hh * 128 + 127];
#pragma unroll
        for (int q = 0; q < 2; ++q) { const int idx = F.tid + 512 * q, p = idx & 63, lc = idx >> 6; const bf16* xb = XA + (size_t)t0 * 1536 + g * 512 + hh * 64; const unsigned off = (unsigned)(8 * lc * 1536 + p);
            float f[8];
#pragma unroll
            for (int j = 0; j < 8; ++j) { const int l = 8 * lc + j; f[j] = bf2f((xb + j * 1536)[off]) * dtv[hh * 128 + l] * __expf(cend - csv[hh * 128 + l]); }
            *(LAS v4u*)(xwT + p * 272 + lc * 16) = (v4u){pk2(f[0], f[1]), pk2(f[2], f[3]), pk2(f[4], f[5]), pk2(f[6], f[7])}; }
        __syncthreads();
        f32x4 acc[4];
#pragma unroll
        for (int tp = 0; tp < 4; ++tp) acc[tp] = (f32x4){0.f, 0.f, 0.f, 0.f};
#pragma unroll
        for (int ks = 0; ks < 4; ++ks)
#pragma unroll
            for (int tp = 0; tp < 4; ++tp) acc[tp] = MFMA16(Bf[ks], ldfrag(xwT, 16 * tp + fr, 272, 32 * ks + 8 * fq), acc[tp]);
#pragma unroll
        for (int tp = 0; tp < 4; ++tp) *(v2u*)(SS + ((size_t)((b * 32 + c) * 16 + h) * 64 + 16 * tp + fr) * 128 + 16 * w + 4 * fq) = (v2u){pk2(acc[tp][0], acc[tp][1]), pk2(acc[tp][2], acc[tp][3])};
        __syncthreads();
    }
}
__device__ __forceinline__ void p4a_gla(const Args& a, Frame& F, int item) {
    const int b = item >> 8, c = (item >> 2) & 63, h = item & 3, t0 = b * SEQ + c * 64;
    const bf16* P = (const bf16*)(a.ws + WS_PROJ); const float* BC = (const float*)(a.ws + WS_GK); bf16* GS = (bf16*)(a.ws + WS_GS); float* GD = (float*)(a.ws + WS_GD);
    ldsp kdT = F.lds, vT = F.lds + 18432;
    const int w = F.wave, fr = F.lane & 15, fq = F.lane >> 4;
#pragma unroll
    for (int q = 0; q < 2; ++q) { const int idx = F.tid + 512 * q, k = idx & 127, lc = idx >> 7;
        const float bl = BC[(size_t)(t0 + 63) * 512 + h * 128 + k]; float f[8];
#pragma unroll
        for (int j = 0; j < 8; ++j) { const int l = 8 * lc + j; f[j] = bf2f(P[(size_t)(t0 + l) * NIN + PK + h * 128 + k]) * __expf(bl - BC[(size_t)(t0 + l) * 512 + h * 128 + k]); }
        *(LAS v4u*)(kdT + k * 144 + lc * 16) = (v4u){pk2(f[0], f[1]), pk2(f[2], f[3]), pk2(f[4], f[5]), pk2(f[6], f[7])};
        if (lc == 0) GD[((b * 64 + c) * 4 + h) * 128 + k] = __expf(bl); }
#pragma unroll
    for (int q = 0; q < 4; ++q) { const int idx = F.tid + 512 * q, v = idx & 255, lc = idx >> 8; const bf16* pb = P + (size_t)t0 * NIN + PV + h * 256; const unsigned off = (unsigned)(8 * lc * NIN + v);
        unsigned e[8];
#pragma unroll
        for (int j = 0; j < 8; ++j) e[j] = (pb + j * NIN)[off];
        *(LAS v4u*)(vT + v * 144 + lc * 16) = (v4u){e[0] | (e[1] << 16), e[2] | (e[3] << 16), e[4] | (e[5] << 16), e[6] | (e[7] << 16)}; }
    __syncthreads();
    bf16x8 Kf[2];
#pragma unroll
    for (int ks = 0; ks < 2; ++ks) Kf[ks] = ldfrag(kdT, 16 * w + fr, 144, 32 * ks + 8 * fq);
#pragma unroll
    for (int tg = 0; tg < 4; ++tg) { f32x4 acc[4];
#pragma unroll
        for (int i = 0; i < 4; ++i) acc[i] = (f32x4){0.f, 0.f, 0.f, 0.f};
#pragma unroll
        for (int ks = 0; ks < 2; ++ks)
#pragma unroll
            for (int i = 0; i < 4; ++i) acc[i] = MFMA16(Kf[ks], ldfrag(vT, 16 * (4 * tg + i) + fr, 144, 32 * ks + 8 * fq), acc[i]);
#pragma unroll
        for (int i = 0; i < 4; ++i) *(v2u*)(GS + ((size_t)((b * 64 + c) * 4 + h) * 256 + 16 * (4 * tg + i) + fr) * 128 + 16 * w + 4 * fq) = (v2u){pk2(acc[i][0], acc[i][1]), pk2(acc[i][2], acc[i][3])}; }
    __syncthreads();
}
__device__ __forceinline__ void p4b_scan(const Args& a, Frame& F) {
    bf16* SS = (bf16*)(a.ws + WS_SS); bf16* GS = (bf16*)(a.ws + WS_GS); const float* CD = (const float*)(a.ws + WS_CD); const float* GD = (const float*)(a.ws + WS_GD);
    for (int gid = F.vcu * 512 + F.tid; gid < 131072; gid += F.G * 512) {
        { const int b = gid >> 15, rem = gid & 32767, h = rem >> 11, r2 = rem & 2047; float run[4] = {0.f, 0.f, 0.f, 0.f};
          for (int c0 = 0; c0 < 32; c0 += 16) { v2u ld[16]; float dec[16];
#pragma unroll
            for (int u = 0; u < 16; ++u) { ld[u] = *(const v2u*)(SS + (size_t)((b * 32 + c0 + u) * 16 + h) * 8192 + r2 * 4); dec[u] = CD[(b * 32 + c0 + u) * 16 + h]; }
#pragma unroll
            for (int u = 0; u < 16; ++u) { *(v2u*)(SS + (size_t)((b * 32 + c0 + u) * 16 + h) * 8192 + r2 * 4) = (v2u){pk2(run[0], run[1]), pk2(run[2], run[3])};
                run[0] = run[0] * dec[u] + bflo(ld[u].x); run[1] = run[1] * dec[u] + bfhi(ld[u].x); run[2] = run[2] * dec[u] + bflo(ld[u].y); run[3] = run[3] * dec[u] + bfhi(ld[u].y); } } }
        { const int b = gid >> 15, rem = gid & 32767, h = rem >> 13, r2 = rem & 8191, k4 = r2 & 31; float run[4] = {0.f, 0.f, 0.f, 0.f};
          for (int c0 = 0; c0 < 64; c0 += 16) { v2u ld[16]; f32x4 dec[16];
#pragma unroll
            for (int u = 0; u < 16; ++u) { ld[u] = *(const v2u*)(GS + (size_t)((b * 64 + c0 + u) * 4 + h) * 32768 + r2 * 4); dec[u] = *(const f32x4*)(GD + ((b * 64 + c0 + u) * 4 + h) * 128 + 4 * k4); }
#pragma unroll
            for (int u = 0; u < 16; ++u) { *(v2u*)(GS + (size_t)((b * 64 + c0 + u) * 4 + h) * 32768 + r2 * 4) = (v2u){pk2(run[0], run[1]), pk2(run[2], run[3])};
                run[0] = run[0] * dec[u].x + bflo(ld[u].x); run[1] = run[1] * dec[u].y + bfhi(ld[u].x); run[2] = run[2] * dec[u].z + bflo(ld[u].y); run[3] = run[3] * dec[u].w + bfhi(ld[u].y); } } }
    }
}
#define LDS_SYNC() asm volatile("s_waitcnt lgkmcnt(0)\n\ts_barrier" ::: "memory")
__device__ __forceinline__ int swz128(int row) { return (((row >> 1) & 1) | (((row >> 3) & 1) << 1)) << 1; }
typedef short v4s_ __attribute__((ext_vector_type(4)));
__device__ __forceinline__ bf16x8 ldfrag_tr128(ldsp tile, int kbase, int c0, int lane) {
    const int g = lane >> 4, q = (lane >> 2) & 3, p = lane & 3, col = (c0 + 4 * p) * 2;
    ldsp ad = tile + (kbase + 8 * g + q) * 128 + ((((col >> 4) ^ (((q >> 1) | ((g & 1) << 1)) << 1)) << 4) | (col & 15));
    const v4s_ lo = __builtin_amdgcn_ds_read_tr16_b64_v4i16((LAS v4s_*)ad), hi = __builtin_amdgcn_ds_read_tr16_b64_v4i16((LAS v4s_*)(ad + 4 * 128));
    return __builtin_shufflevector(lo, hi, 0, 1, 2, 3, 4, 5, 6, 7);
}
__device__ __forceinline__ int swz256(int row) { return ((row & 3) | (((row >> 3) & 1) << 2)) << 1; }
__device__ __forceinline__ bf16x8 ldfrag_tr512(ldsp tile, int kbase, int c0, int lane) {
    const int g = lane >> 4, q = (lane >> 2) & 3, p = lane & 3, col = (c0 + 4 * p) * 2;
    ldsp ad = tile + (kbase + 8 * g + q) * 512 + ((((col >> 4) ^ ((q | ((g & 1) << 2)) << 1)) << 4) | (col & 15));
    const v4s_ lo = __builtin_amdgcn_ds_read_tr16_b64_v4i16((LAS v4s_*)ad), hi = __builtin_amdgcn_ds_read_tr16_b64_v4i16((LAS v4s_*)(ad + 4 * 512));
    return __builtin_shufflevector(lo, hi, 0, 1, 2, 3, 4, 5, 6, 7);
}
__device__ __forceinline__ void p4c_ssd(const Args& a, Frame& F, int item) {
    const int b = item >> 6, c = (item >> 1) & 31, g = item & 1, t0 = b * SEQ + c * 128;
    const bf16* P = (const bf16*)(a.ws + WS_PROJ); const bf16* XA = (const bf16*)a.out; const bf16* SS = (const bf16*)(a.ws + WS_SS); bf16* MX = (bf16*)(a.ws + WS_MIX);
    const float* dsk = a.in[10]; const float* sng = a.in[11];
    ldsp Cs = F.lds, Ms0 = F.lds + 34816; LAS float* dtv = (LAS float*)(F.lds + 104448); LAS float* csv = dtv + 1024;
    const int w = (F.wave < 4) ? F.wave : 11 - F.wave, fr = F.lane & 15, fq = F.lane >> 4, l = 16 * w + fr;
    v4u xr[2], pr[2]; v2u zr[4];
    auto ld_head = [&](int hn) {
#pragma unroll
        for (int q = 0; q < 2; ++q) { const int idx = F.tid + 512 * q; xr[q] = *(const v4u*)(XA + (size_t)(t0 + (idx >> 3)) * 1536 + g * 512 + hn * 64 + 8 * (idx & 7)); }
#pragma unroll
        for (int q = 0; q < 2; ++q) { const int idx = F.tid + 512 * q; pr[q] = *(const v4u*)(SS + ((size_t)((b * 32 + c) * 16 + g * 8 + hn) * 64 + (idx >> 4)) * 128 + 8 * (idx & 15)); }
#pragma unroll
        for (int tp = 0; tp < 4; ++tp) zr[tp] = *(const v2u*)(P + (size_t)(t0 + l) * NIN + PZ + g * 512 + hn * 64 + 16 * tp + 4 * fq);
    };
    ld_head(0);
    ssd_dtcs(a, F, b, c, g, dtv, csv, nullptr);
    LAS float* dskl = (LAS float*)(F.lds + 147456);
    LAS float* gaml = (LAS float*)(F.lds + 147520);
    if (F.tid < 8) dskl[F.tid] = dsk[g * 8 + F.tid];
    if (F.tid < 128) *(LAS f32x4*)(gaml + 4 * F.tid) = *(const f32x4*)(sng + g * 512 + 4 * F.tid);
#pragma unroll
    for (int q = 0; q < 4; ++q) { const int idx = F.tid + 512 * q, ll = idx >> 4, ch = idx & 15;
        *(LAS v4u*)(Cs + ll * 272 + ch * 16) = *(const v4u*)(XA + (size_t)(t0 + ll) * 1536 + 1280 + g * 128 + 8 * ch);
        *(LAS v4u*)(Ms0 + ll * 272 + ch * 16) = *(const v4u*)(XA + (size_t)(t0 + ll) * 1536 + 1024 + g * 128 + 8 * ch); }
    __syncthreads();
    bf16x8 Cf[4];
#pragma unroll
    for (int ks = 0; ks < 4; ++ks) Cf[ks] = ldfrag(Cs, l, 272, 32 * ks + 8 * fq);
    f32x4 cb[8];
#pragma unroll
    for (int ts = 0; ts < 8; ++ts) { cb[ts] = (f32x4){0.f, 0.f, 0.f, 0.f};
        if (ts <= w) {
#pragma unroll
            for (int ks = 0; ks < 4; ++ks) cb[ts] = MFMA16(ldfrag(Ms0, 16 * ts + fr, 272, 32 * ks + 8 * fq), Cf[ks], cb[ts]); } }
    __syncthreads();
    float ssq = 0.f;
#pragma unroll 1
    for (int hh = 0; hh < 8; ++hh) {
        const bool odd = (hh & 1) != 0; ldsp Ms = odd ? F.lds : F.lds + 34816; ldsp xs = odd ? F.lds + 112640 : F.lds + 69632; ldsp prevs = odd ? F.lds + 130048 : F.lds + 87040;
#pragma unroll
        for (int q = 0; q < 2; ++q) { const int idx = F.tid + 512 * q, row = idx >> 3, ch = idx & 7; *(LAS v4u*)(xs + row * 128 + ((ch ^ swz128(row)) << 4)) = xr[q]; }
#pragma unroll
        for (int q = 0; q < 2; ++q) { const int idx = F.tid + 512 * q, p = idx >> 4, ch = idx & 15; *(LAS v4u*)(prevs + p * 272 + ch * 16) = pr[q]; }
        v2u zc[4];
#pragma unroll
        for (int tp = 0; tp < 4; ++tp) zc[tp] = zr[tp];
        const float csl = csv[hh * 128 + l];
#pragma unroll
        for (int ts = 0; ts < 8; ++ts) { float m[4] = {0.f, 0.f, 0.f, 0.f};
            if (ts <= w) { const f32x4 c4 = *(const LAS f32x4*)(csv + hh * 128 + 16 * ts + 4 * fq), d4 = *(const LAS f32x4*)(dtv + hh * 128 + 16 * ts + 4 * fq);
#pragma unroll
                for (int j = 0; j < 4; ++j) { const int s = 16 * ts + 4 * fq + j; const float v = cb[ts][j] * __expf(fminf(csl - c4[j], 0.f)) * d4[j]; m[j] = (s <= l) ? v : 0.f; } }
            *(LAS v2u*)(Ms + l * 272 + (16 * ts + 4 * fq) * 2) = (v2u){pk2(m[0], m[1]), pk2(m[2], m[3])}; }
        LDS_SYNC();
        if (hh + 1 < 8) ld_head(hh + 1);
        f32x4 y1[4], y2[4];
#pragma unroll
        for (int tp = 0; tp < 4; ++tp) { y1[tp] = (f32x4){0.f, 0.f, 0.f, 0.f}; y2[tp] = (f32x4){0.f, 0.f, 0.f, 0.f}; }
        const int ksmax = (16 * w + 15) >> 5;
        for (int ks = 0; ks <= ksmax; ++ks) { const bf16x8 Mf = ldfrag(Ms, l, 272, 32 * ks + 8 * fq);
#pragma unroll
            for (int tp = 0; tp < 4; ++tp) y1[tp] = MFMA16(ldfrag_tr128(xs, 32 * ks, 16 * tp, F.lane), Mf, y1[tp]); }
#pragma unroll
        for (int ks = 0; ks < 4; ++ks)
#pragma unroll
            for (int tp = 0; tp < 4; ++tp) y2[tp] = MFMA16(ldfrag(prevs, 16 * tp + fr, 272, 32 * ks + 8 * fq), Cf[ks], y2[tp]);
        const float el = __expf(csl), dk = dskl[hh];
#pragma unroll
        for (int tp = 0; tp < 4; ++tp) { const int p0 = 16 * tp + 4 * fq; const v2u zz = zc[tp];
            const float zf[4] = {bflo(zz.x), bfhi(zz.x), bflo(zz.y), bfhi(zz.y)}; float u[4];
            const v2u x4 = *(const LAS v2u*)(xs + l * 128 + ((((p0 * 2) >> 4) ^ swz128(l)) << 4) + ((p0 * 2) & 15)); const float xf[4] = {bflo(x4.x), bfhi(x4.x), bflo(x4.y), bfhi(x4.y)};
#pragma unroll
            for (int j = 0; j < 4; ++j) { const float y = y1[tp][j] + y2[tp][j] * el + dk * xf[j]; u[j] = y * silu_f(zf[j]); ssq += u[j] * u[j]; }
            *(v2u*)(MX + (size_t)(t0 + l) * 2048 + g * 512 + hh * 64 + p0) = (v2u){pk2(u[0], u[1]), pk2(u[2], u[3])}; }
    }
    __syncthreads();
    ssq += __shfl_xor(ssq, 16); ssq += __shfl_xor(ssq, 32);
    const float rstd = 1.f / sqrtf(ssq * (1.f / 512.f) + EPS);
    LAS float* rsl = (LAS float*)(F.lds + 149568);
    if (fq == 0) rsl[l] = rstd;
    VM_WAIT();
    __syncthreads();
#pragma unroll 1
    for (int hb = 0; hb < 2; ++hb) {
        v4u wv[8];
#pragma unroll
        for (int i = 0; i < 8; ++i) { const int id = (8 * hb + i) * 512 + F.tid; wv[i] = *(const v4u*)(MX + (size_t)(t0 + (id >> 6)) * 2048 + g * 512 + 8 * (id & 63)); }
        asm volatile("" ::: "memory");
#pragma unroll
        for (int i = 0; i < 8; ++i) { const int id = (8 * hb + i) * 512 + F.tid, row = id >> 6, c8 = 8 * (id & 63); const float r = rsl[row];
            const f32x4 g0 = *(const LAS f32x4*)(gaml + c8), g1 = *(const LAS f32x4*)(gaml + c8 + 4);
            *(v4u*)(MX + (size_t)(t0 + row) * 2048 + g * 512 + c8) = (v4u){pk2(bflo(wv[i].x) * r * g0.x, bfhi(wv[i].x) * r * g0.y), pk2(bflo(wv[i].y) * r * g0.z, bfhi(wv[i].y) * r * g0.w),
                                                                          pk2(bflo(wv[i].z) * r * g1.x, bfhi(wv[i].z) * r * g1.y), pk2(bflo(wv[i].w) * r * g1.z, bfhi(wv[i].w) * r * g1.w)}; }
    }
    __syncthreads();
}
struct GlaStage { v4u q8[2], k8[2]; f32x4 b0[2], b1[2]; };
__device__ __forceinline__ void gla_stage_load(GlaStage& S, const Args& a, Frame& F, int item) {
    const int b = item >> 8, c = (item >> 2) & 63, h = item & 3, t0 = b * SEQ + c * 64;
    const bf16* P = (const bf16*)(a.ws + WS_PROJ); const float* BC = (const float*)(a.ws + WS_GK);
#pragma unroll
    for (int q = 0; q < 2; ++q) { const int idx = F.tid + 512 * q, l = idx >> 4, ch = idx & 15;
        S.q8[q] = *(const v4u*)(P + (size_t)(t0 + l) * NIN + PQ + h * 128 + 8 * ch); S.k8[q] = *(const v4u*)(P + (size_t)(t0 + l) * NIN + PK + h * 128 + 8 * ch);
        const f32x4* bp = (const f32x4*)(BC + (size_t)(t0 + l) * 512 + h * 128 + 8 * ch); S.b0[q] = bp[0]; S.b1[q] = bp[1]; }
}
__device__ __forceinline__ void p4c_gla(const Args& a, Frame& F, int item, GlaStage& S, int next_item) {
    const int b = item >> 8, c = (item >> 2) & 63, h = item & 3, t0 = b * SEQ + c * 64;
    const bf16* P = (const bf16*)(a.ws + WS_PROJ); const float* BC = (const float*)(a.ws + WS_GK); const bf16* GS = (const bf16*)(a.ws + WS_GS); bf16* MX = (bf16*)(a.ws + WS_MIX); const float* gng = a.in[14];
    ldsp qt = F.lds, kt = F.lds + 17408, att = F.lds + 34816, vT = F.lds + 44032; LAS float* part = (LAS float*)(F.lds + 80896);
    const int w = F.wave, fr = F.lane & 15, fq = F.lane >> 4;
    bf16x8 PF[2][4]; v2u rrv[4][2]; v4u vv[4];
#pragma unroll
    for (int q = 0; q < 4; ++q) { const int idx = F.tid + 512 * q, row = idx >> 5, ch = idx & 31; vv[q] = *(const v4u*)(P + (size_t)(t0 + row) * NIN + PV + h * 256 + 8 * ch); }
#pragma unroll
    for (int tl = 0; tl < 4; ++tl)
#pragma unroll
        for (int tvi = 0; tvi < 2; ++tvi) rrv[tl][tvi] = *(const v2u*)(P + (size_t)(t0 + 16 * tl + fr) * NIN + PR + h * 256 + 16 * (2 * w + tvi) + 4 * fq);
#pragma unroll
    for (int q = 0; q < 2; ++q) { const int idx = F.tid + 512 * q, l = idx >> 4, ch = idx & 15;
        const v4u q8 = S.q8[q], k8 = S.k8[q]; const f32x4 b0 = S.b0[q], b1 = S.b1[q];
        const float bc[8] = {b0.x, b0.y, b0.z, b0.w, b1.x, b1.y, b1.z, b1.w}; const unsigned qw[4] = {q8.x, q8.y, q8.z, q8.w}, kw[4] = {k8.x, k8.y, k8.z, k8.w}; unsigned qo[4], ko[4];
#pragma unroll
        for (int j = 0; j < 4; ++j) { const float e0 = __expf(bc[2 * j]), e1 = __expf(bc[2 * j + 1]), i0 = __expf(-bc[2 * j]), i1 = __expf(-bc[2 * j + 1]);
            qo[j] = pk2(bflo(qw[j]) * e0 * QSCALE, bfhi(qw[j]) * e1 * QSCALE); ko[j] = pk2(bflo(kw[j]) * i0, bfhi(kw[j]) * i1); }
        *(LAS v4u*)(qt + l * 272 + ch * 16) = (v4u){qo[0], qo[1], qo[2], qo[3]}; *(LAS v4u*)(kt + l * 272 + ch * 16) = (v4u){ko[0], ko[1], ko[2], ko[3]}; }
    asm volatile("" ::: "memory");
    LDS_SYNC();
    if (next_item >= 0) gla_stage_load(S, a, F, next_item);
#pragma unroll
    for (int tvi = 0; tvi < 2; ++tvi)
#pragma unroll
        for (int ks = 0; ks < 4; ++ks) PF[tvi][ks] = *(const bf16x8*)(GS + ((size_t)((b * 64 + c) * 4 + h) * 256 + 16 * (2 * w + tvi) + fr) * 128 + 32 * ks + 8 * fq);
#pragma unroll
    for (int ti = 0; ti < 2; ++ti) { const int id = 2 * w + ti, tl = id >> 2, ts = id & 3; f32x4 acc = (f32x4){0.f, 0.f, 0.f, 0.f};
        if (ts <= tl) {
#pragma unroll
            for (int ks = 0; ks < 4; ++ks) acc = MFMA16(ldfrag(kt, 16 * ts + fr, 272, 32 * ks + 8 * fq), ldfrag(qt, 16 * tl + fr, 272, 32 * ks + 8 * fq), acc); }
        const int l = 16 * tl + fr; float m[4];
#pragma unroll
        for (int j = 0; j < 4; ++j) { const int s = 16 * ts + 4 * fq + j; m[j] = (s <= l) ? acc[j] : 0.f; }
        *(LAS v2u*)(att + l * 144 + (16 * ts + 4 * fq) * 2) = (v2u){pk2(m[0], m[1]), pk2(m[2], m[3])}; }
#pragma unroll
    for (int q = 0; q < 4; ++q) { const int idx = F.tid + 512 * q, row = idx >> 5, ch = idx & 31; *(LAS v4u*)(vT + row * 512 + ((ch ^ swz256(row)) << 4)) = vv[q]; }
    LDS_SYNC();
    f32x4 o[4][2];
#pragma unroll
    for (int tl = 0; tl < 4; ++tl) {
        bf16x8 af[2], qf[4];
#pragma unroll
        for (int ks = 0; ks < 2; ++ks) af[ks] = ldfrag(att, 16 * tl + fr, 144, 32 * ks + 8 * fq);
#pragma unroll
        for (int ks = 0; ks < 4; ++ks) qf[ks] = ldfrag(qt, 16 * tl + fr, 272, 32 * ks + 8 * fq);
        f32x4 a0 = (f32x4){0.f, 0.f, 0.f, 0.f}, a1 = (f32x4){0.f, 0.f, 0.f, 0.f};
#pragma unroll
        for (int ks = 0; ks < 2; ++ks) { a0 = MFMA16(ldfrag_tr512(vT, 32 * ks, 16 * (2 * w), F.lane), af[ks], a0); a1 = MFMA16(ldfrag_tr512(vT, 32 * ks, 16 * (2 * w + 1), F.lane), af[ks], a1); }
#pragma unroll
        for (int ks = 0; ks < 4; ++ks) { a0 = MFMA16(PF[0][ks], qf[ks], a0); a1 = MFMA16(PF[1][ks], qf[ks], a1); }
        o[tl][0] = a0; o[tl][1] = a1;
    }
#pragma unroll
    for (int tl = 0; tl < 4; ++tl) { float s = 0.f;
#pragma unroll
        for (int tvi = 0; tvi < 2; ++tvi)
#pragma unroll
            for (int j = 0; j < 4; ++j) s += o[tl][tvi][j] * o[tl][tvi][j];
        s += __shfl_xor(s, 16); s += __shfl_xor(s, 32);
        if (fq == 0) part[w * 64 + 16 * tl + fr] = s; }
    LDS_SYNC();
#pragma unroll
    for (int tl = 0; tl < 4; ++tl) { const int l = 16 * tl + fr; float tot = 0.f;
#pragma unroll
        for (int w8 = 0; w8 < 8; ++w8) tot += part[w8 * 64 + l];
        const float rstd = 1.f / sqrtf(tot * (1.f / 256.f) + EPS);
#pragma unroll
        for (int tvi = 0; tvi < 2; ++tvi) { const int v0 = 16 * (2 * w + tvi) + 4 * fq; const v2u rr = rrv[tl][tvi]; const f32x4 gg = *(const f32x4*)(gng + v0);
            const f32x4 ov = o[tl][tvi];
            *(v2u*)(MX + (size_t)(t0 + l) * 2048 + 1024 + h * 256 + v0) = (v2u){pk2(ov[0] * rstd * gg.x * silu_f(bflo(rr.x)), ov[1] * rstd * gg.y * silu_f(bfhi(rr.x))), pk2(ov[2] * rstd * gg.z * silu_f(bflo(rr.y)), ov[3] * rstd * gg.w * silu_f(bfhi(rr.y)))}; } }
    LDS_SYNC();
}
__device__ __forceinline__ void lds_put16(ldsp base, int off, unsigned v) { *(LAS unsigned short*)(base + off) = (unsigned short)v; }
typedef short v4s __attribute__((ext_vector_type(4)));
__device__ __forceinline__ bf16x8 ldfrag_tr(ldsp tile, int stride, int kbase, int c0, int lane) {
    const int g = lane >> 4, q = (lane >> 2) & 3, p = lane & 3;
    ldsp ad = tile + (kbase + 8 * g + q) * stride + (c0 + 4 * p) * 2;
    const v4s lo = __builtin_amdgcn_ds_read_tr16_b64_v4i16((LAS v4s*)ad), hi = __builtin_amdgcn_ds_read_tr16_b64_v4i16((LAS v4s*)(ad + 4 * stride));
    return __builtin_shufflevector(lo, hi, 0, 1, 2, 3, 4, 5, 6, 7);
}
__device__ __forceinline__ void glds16(const char* g, ldsp l) { __builtin_amdgcn_global_load_lds((const unsigned*)g, (LAS unsigned*)l, 16, 0, 0); }
__device__ __forceinline__ void glds4(const char* g, ldsp l) { __builtin_amdgcn_global_load_lds((const unsigned*)g, (LAS unsigned*)l, 4, 0, 0); }
template <int N> __device__ __forceinline__ void wait_vm() { asm volatile("s_waitcnt vmcnt(%0)" :: "n"(N) : "memory"); }
struct TrFrag { v2u lo, hi; };
template <int OFF> __device__ __forceinline__ v2u ds_tr_b64(unsigned addr) { v2u r; asm volatile("ds_read_b64_tr_b16 %0, %1 offset:%2" : "=v"(r) : "v"(addr), "n"(OFF) : "memory"); return r; }
template <int KB, int TOFF> __device__ __forceinline__ TrFrag tr256(unsigned sbase, int c0, int lane) {
    const int g = lane >> 4, q = (lane >> 2) & 3, p = lane & 3, col = (c0 + 4 * p) * 2;
    const unsigned ad = sbase + (unsigned)((8 * g + q) * 256 + ((((col >> 4) ^ ((q | ((g & 1) << 2)) << 1)) << 4) | (col & 15)));
    TrFrag f; f.lo = ds_tr_b64<TOFF + KB * 256>(ad); f.hi = ds_tr_b64<TOFF + KB * 256 + 1024>(ad); return f;
}
template <int KB, int TOFF> __device__ __forceinline__ TrFrag tr128(unsigned sbase, int c0, int lane) {
    const int g = lane >> 4, q = (lane >> 2) & 3, p = lane & 3, col = (c0 + 4 * p) * 2;
    const unsigned ad = sbase + (unsigned)((8 * g + q) * 128 + ((((col >> 4) ^ (((q >> 1) | ((g & 1) << 1)) << 1)) << 4) | (col & 15)));
    TrFrag f; f.lo = ds_tr_b64<TOFF + KB * 128>(ad); f.hi = ds_tr_b64<TOFF + KB * 128 + 512>(ad); return f;
}
__device__ __forceinline__ bf16x8 frag8(const TrFrag& f) { return __builtin_bit_cast(bf16x8, (v4u){f.lo.x, f.lo.y, f.hi.x, f.hi.y}); }
#define TR_TIE5(f0, f1, f2, f3, f4) asm volatile("s_waitcnt lgkmcnt(0)" : "+v"(f0.lo), "+v"(f0.hi), "+v"(f1.lo), "+v"(f1.hi), "+v"(f2.lo), "+v"(f2.hi), "+v"(f3.lo), "+v"(f3.hi), "+v"(f4.lo), "+v"(f4.hi) :: "memory")
constexpr int CH_DP = 5, CH_SLOT = 25600, CH_NL = 7, CH_STG = CH_DP * CH_SLOT, CH_STG_BYTES = 64 * 272, CH_DUMP = CH_STG + 2 * CH_STG_BYTES + 128, CH_WARM = 6;
__device__ __forceinline__ void ch_stage_state(ldsp stg, const f32x4 (&S)[2][4], int w, int fr, int fq) {
#pragma unroll
    for (int rb = 0; rb < 2; ++rb)
#pragma unroll
        for (int t = 0; t < 4; ++t) *(LAS v2u*)(stg + (16 * t + fr) * 272 + (32 * w + 16 * rb + 4 * fq) * 2) = (v2u){pk2(S[rb][t][0], S[rb][t][1]), pk2(S[rb][t][2], S[rb][t][3])};
}
__device__ __forceinline__ void ch_store_state(ldsp stg, char* dst, int t) {
    v4u r[4];
#pragma unroll
    for (int i = 0; i < 4; ++i) { const int id = i * 256 + t; r[i] = *(const LAS v4u*)(stg + (id >> 4) * 272 + (id & 15) * 16); }
#pragma unroll
    for (int i = 0; i < 4; ++i) *(v4u*)(dst + (size_t)(i * 256 + t) * 16) = r[i];
}
__device__ __forceinline__ void st_ssd_chain(const Args& a, Frame& F, int id) {
    const int b = id >> 4, h = id & 15, g = h >> 3, w = F.wave, lane = F.lane, fr = lane & 15, fq = lane >> 4;
    const char* XA = (const char*)a.out; const char* SW = (const char*)(a.ws + WS_SW); const float* SCD = (const float*)(a.ws + WS_SCD); char* SS = (char*)(a.ws + WS_SS);
    LAS float* dect = (LAS float*)(F.lds + CH_STG + 2 * CH_STG_BYTES);
    if (F.tid < 32) dect[F.tid] = SCD[(b * 32 + F.tid) * 16 + h];
    if (w >= 4) {
        const int t = F.tid - 256;
        const unsigned owarm = (t < 128) ? (unsigned)((t >> 1) * 3072 + (1024 + g * 128) * 2 + (t & 1) * 128) : (t < 192) ? (unsigned)((t - 128) * 3072 + h * 128) : 0xffffffffu;
        for (int hs = 0; hs <= 62; ++hs) {
            LDS_SYNC();
            if ((hs & 1) == 0) { const int c = hs >> 1; ch_store_state(F.lds + CH_STG + (c & 1) * CH_STG_BYTES, SS + ((size_t)((b * 32 + c) * 16 + h)) * 16384, t); }
            { const int hw = hs + CH_WARM <= 61 ? hs + CH_WARM : 61; const int t0 = b * SEQ + hw * 64;
              const char* wp = (owarm != 0xffffffffu) ? XA + (size_t)t0 * 3072 + owarm : SW + (size_t)t0 * 64 + (unsigned)(((t - 192) & 31) * 128 + h * 4);
              glds4(wp, F.lds + CH_DUMP); }
        }
        LDS_SYNC();
        return;
    }
    unsigned ob[4], ox[2], owv;
#pragma unroll
    for (int i = 0; i < 4; ++i) { const int A = (i * 4 + w) * 1024 + lane * 16, row = A >> 8, lc = ((A >> 4) & 15) ^ swz256(row); ob[i] = (unsigned)(row * 3072 + (1024 + g * 128) * 2 + lc * 16); }
#pragma unroll
    for (int i = 0; i < 2; ++i) { const int A = (i * 4 + w) * 1024 + lane * 16, row = A >> 7, lc = ((A >> 4) & 7) ^ swz128(row); ox[i] = (unsigned)(row * 3072 + h * 128 + lc * 16); }
    owv = (unsigned)((lane * 16 + h) * 4);
    auto issue = [&](int hs, int slot) {
        const int t0 = b * SEQ + hs * 64; const char* xb = XA + (size_t)t0 * 3072; const char* wb = SW + (size_t)t0 * 64; ldsp s = F.lds + slot * CH_SLOT;
#pragma unroll
        for (int i = 0; i < 4; ++i) glds16(xb + ob[i], s + (i * 4 + w) * 1024);
#pragma unroll
        for (int i = 0; i < 2; ++i) glds16(xb + ox[i], s + 16384 + (i * 4 + w) * 1024);
        glds4(wb + owv, s + 24576);
    };
    f32x4 S[2][4];
#pragma unroll
    for (int rb = 0; rb < 2; ++rb)
#pragma unroll
        for (int tp = 0; tp < 4; ++tp) S[rb][tp] = (f32x4){0.f, 0.f, 0.f, 0.f};
    asm volatile("s_waitcnt vmcnt(0)" ::: "memory");
#pragma unroll
    for (int j = 0; j < CH_DP - 1; ++j) issue(j, j);
    int slot = 0, nslot = CH_DP - 1;
    for (int hs = 0; hs <= 62; ++hs) {
        const int c = hs >> 1;
        if ((hs & 1) == 0) ch_stage_state(F.lds + CH_STG + (c & 1) * CH_STG_BYTES, S, w, fr, fq);
        wait_vm<(CH_DP - 2) * CH_NL>();
        LDS_SYNC();
        if (hs == 62) break;
        { const int hn = hs + CH_DP - 1; issue(hn <= 61 ? hn : 61, nslot); }
        ldsp s = F.lds + slot * CH_SLOT; const unsigned sb = (unsigned)(size_t)s;
        TrFrag Bq[2][2], xq[2][4];
#pragma unroll
        for (int rb = 0; rb < 2; ++rb) { Bq[0][rb] = tr256<0, 0>(sb, 32 * w + 16 * rb, lane); Bq[1][rb] = tr256<32, 0>(sb, 32 * w + 16 * rb, lane); }
#pragma unroll
        for (int tp = 0; tp < 4; ++tp) { xq[0][tp] = tr128<0, 16384>(sb, 16 * tp, lane); xq[1][tp] = tr128<32, 16384>(sb, 16 * tp, lane); }
        if ((hs & 1) == 0) { const float dec = dect[c];
#pragma unroll
            for (int rb = 0; rb < 2; ++rb)
#pragma unroll
                for (int tp = 0; tp < 4; ++tp) S[rb][tp] = S[rb][tp] * dec; }
        TR_TIE5(Bq[0][0], Bq[0][1], Bq[1][0], Bq[1][1], xq[0][0]); TR_TIE5(xq[0][1], xq[0][2], xq[0][3], xq[1][0], xq[1][1]);
        asm volatile("s_waitcnt lgkmcnt(0)" : "+v"(xq[1][2].lo), "+v"(xq[1][2].hi), "+v"(xq[1][3].lo), "+v"(xq[1][3].hi) :: "memory");
#pragma unroll
        for (int ks = 0; ks < 2; ++ks) {
            const f32x4 w0 = *(const LAS f32x4*)(s + 24576 + (32 * ks + 8 * fq) * 4), w1 = *(const LAS f32x4*)(s + 24576 + (32 * ks + 8 * fq + 4) * 4);
#pragma unroll
            for (int rb = 0; rb < 2; ++rb) {
                const v4u bw = {Bq[ks][rb].lo.x, Bq[ks][rb].lo.y, Bq[ks][rb].hi.x, Bq[ks][rb].hi.y};
                const v4u bs = {pk2(bflo(bw.x) * w0.x, bfhi(bw.x) * w0.y), pk2(bflo(bw.y) * w0.z, bfhi(bw.y) * w0.w), pk2(bflo(bw.z) * w1.x, bfhi(bw.z) * w1.y), pk2(bflo(bw.w) * w1.z, bfhi(bw.w) * w1.w)};
                const bf16x8 Bf = __builtin_bit_cast(bf16x8, bs);
#pragma unroll
                for (int tp = 0; tp < 4; ++tp) S[rb][tp] = MFMA16(Bf, frag8(xq[ks][tp]), S[rb][tp]); } }
        slot = (slot + 1 == CH_DP) ? 0 : slot + 1; nslot = (nslot + 1 == CH_DP) ? 0 : nslot + 1;
    }
    wait_vm<0>();
    LDS_SYNC();
}
__device__ __forceinline__ void st_gla_chain(const Args& a, Frame& F, int id) {
    const int b = id >> 4, h = (id >> 2) & 3, vq = id & 3, w = F.wave, lane = F.lane, fr = lane & 15, fq = lane >> 4;
    const char* KD = (const char*)(a.ws + WS_KD); const char* P = (const char*)(a.ws + WS_PROJ); const char* DKL = (const char*)(a.ws + WS_DKL); char* GS = (char*)(a.ws + WS_GS);
    if (w >= 4) {
        const int t = F.tid - 256;
        for (int c = 0; c <= 63; ++c) {
            LDS_SYNC();
            ch_store_state(F.lds + CH_STG + (c & 1) * CH_STG_BYTES, GS + (((size_t)((b * 64 + c) * 4 + h)) * 256 + vq * 64) * 256, t);
            { const int cw = c + CH_WARM <= 62 ? c + CH_WARM : 62; const int t0 = b * SEQ + cw * 64;
              const char* wp = (t < 128) ? KD + (size_t)(t0 + (t >> 1)) * 1024 + h * 256 + (t & 1) * 128
                             : (t < 192) ? P + (size_t)(t0 + (t - 128)) * (NIN * 2) + (PV + h * 256 + vq * 64) * 2
                                         : DKL + ((size_t)(b * 64 + cw) * 512 + h * 128) * 4 + ((t - 192) & 3) * 128;
              glds4(wp, F.lds + CH_DUMP); }
        }
        LDS_SYNC();
        return;
    }
    unsigned okd[4], ov[2];
#pragma unroll
    for (int i = 0; i < 4; ++i) { const int A = (i * 4 + w) * 1024 + lane * 16, row = A >> 8, lc = ((A >> 4) & 15) ^ swz256(row); okd[i] = (unsigned)(row * 1024 + h * 256 + lc * 16); }
#pragma unroll
    for (int i = 0; i < 2; ++i) { const int A = (i * 4 + w) * 1024 + lane * 16, row = A >> 7, lc = ((A >> 4) & 7) ^ swz128(row); ov[i] = (unsigned)(row * (NIN * 2) + (PV + h * 256 + vq * 64) * 2 + lc * 16); }
    auto issue = [&](int c, int slot) {
        const int t0 = b * SEQ + c * 64; const char* kb = KD + (size_t)t0 * 1024; const char* pb = P + (size_t)t0 * (NIN * 2); const char* db = DKL + ((size_t)(b * 64 + c) * 512 + h * 128) * 4; ldsp s = F.lds + slot * CH_SLOT;
#pragma unroll
        for (int i = 0; i < 4; ++i) glds16(kb + okd[i], s + (i * 4 + w) * 1024);
#pragma unroll
        for (int i = 0; i < 2; ++i) glds16(pb + ov[i], s + 16384 + (i * 4 + w) * 1024);
        glds16(db + lane * 16, s + 24576);
    };
    f32x4 S[2][4];
#pragma unroll
    for (int rb = 0; rb < 2; ++rb)
#pragma unroll
        for (int tv = 0; tv < 4; ++tv) S[rb][tv] = (f32x4){0.f, 0.f, 0.f, 0.f};
    asm volatile("s_waitcnt vmcnt(0)" ::: "memory");
#pragma unroll
    for (int j = 0; j < CH_DP - 1; ++j) issue(j, j);
    int slot = 0, nslot = CH_DP - 1;
    for (int c = 0; c <= 63; ++c) {
        ch_stage_state(F.lds + CH_STG + (c & 1) * CH_STG_BYTES, S, w, fr, fq);
        wait_vm<(CH_DP - 2) * CH_NL>();
        LDS_SYNC();
        if (c == 63) break;
        { const int cn = c + CH_DP - 1; issue(cn <= 62 ? cn : 62, nslot); }
        ldsp s = F.lds + slot * CH_SLOT; const unsigned sb = (unsigned)(size_t)s;
        TrFrag Kq[2][2], vq2[2][4];
#pragma unroll
        for (int rb = 0; rb < 2; ++rb) { Kq[0][rb] = tr256<0, 0>(sb, 32 * w + 16 * rb, lane); Kq[1][rb] = tr256<32, 0>(sb, 32 * w + 16 * rb, lane); }
#pragma unroll
        for (int tv = 0; tv < 4; ++tv) { vq2[0][tv] = tr128<0, 16384>(sb, 16 * tv, lane); vq2[1][tv] = tr128<32, 16384>(sb, 16 * tv, lane); }
#pragma unroll
        for (int rb = 0; rb < 2; ++rb) { const f32x4 dk4 = *(const LAS f32x4*)(s + 24576 + (32 * w + 16 * rb + 4 * fq) * 4);
#pragma unroll
            for (int tv = 0; tv < 4; ++tv) S[rb][tv] = S[rb][tv] * dk4; }
        TR_TIE5(Kq[0][0], Kq[0][1], Kq[1][0], Kq[1][1], vq2[0][0]); TR_TIE5(vq2[0][1], vq2[0][2], vq2[0][3], vq2[1][0], vq2[1][1]);
        asm volatile("s_waitcnt lgkmcnt(0)" : "+v"(vq2[1][2].lo), "+v"(vq2[1][2].hi), "+v"(vq2[1][3].lo), "+v"(vq2[1][3].hi) :: "memory");
#pragma unroll
        for (int ks = 0; ks < 2; ++ks)
#pragma unroll
            for (int rb = 0; rb < 2; ++rb)
#pragma unroll
                for (int tv = 0; tv < 4; ++tv) S[rb][tv] = MFMA16(frag8(Kq[ks][rb]), frag8(vq2[ks][tv]), S[rb][tv]);
        slot = (slot + 1 == CH_DP) ? 0 : slot + 1; nslot = (nslot + 1 == CH_DP) ? 0 : nslot + 1;
    }
    wait_vm<0>();
    LDS_SYNC();
}
__device__ __forceinline__ void phase6b_range(const Args& a, Frame& F, int cw, int ncw);
__device__ __forceinline__ void phase6b_tickets(const Args& a, Frame& F);
constexpr int CV_DP = 4, CV_SLOT = 32768, CV_T = CV_DP * CV_SLOT, CV_TB = 64 * 144, CV_STEPS = 96 * 128;
#ifndef CV_OWNER_STEPS
#define CV_OWNER_STEPS 24
#endif
constexpr int CV_EARLY_WGS = 64, CV_EARLY_STEPS = 24, CV_EARLY = CV_EARLY_WGS * CV_EARLY_STEPS;
__device__ __forceinline__ void cv_mat(int m, int& e, int& kind) { if (m < 48) { e = m >> 1; kind = m & 1; } else if (m < 80) { e = m - 48; kind = 2; } else { e = 24 + ((m - 80) >> 1); kind = (m - 80) & 1; } }
__device__ __forceinline__ void cvt_stream(const Args& a, Frame& F, int sid0, int stride, int nst);
__device__ __forceinline__ void phase_states(const Args& a, Frame& F) {
    for (int r = F.vcu; r < 256; r += F.G) {
        const int xcd = r >> 5, idx = r & 31;
        if (idx < 8) st_ssd_chain(a, F, xcd * 8 + idx);
        else if (idx < 16) st_gla_chain(a, F, xcd * 8 + idx - 8);
        { constexpr int REST = CV_STEPS - CV_EARLY, NOWN = 128 * CV_OWNER_STEPS, NOTH = (REST - NOWN) / 128; static_assert((REST - NOWN) % 128 == 0, "tile split");
          const int j = xcd * 16 + (idx & 15);
          if (idx < 16) cvt_stream(a, F, CV_EARLY + 128 * NOTH + j, 128, CV_OWNER_STEPS); else cvt_stream(a, F, CV_EARLY + j, 128, NOTH); }
    }
}
__device__ __forceinline__ void phase4a(const Args& a, Frame& F) { for (int it = F.vcu; it < 1280; it += F.G) { if (it < 256) p4a_ssd(a, F, it); else p4a_gla(a, F, it - 256); } }
__device__ __forceinline__ void phase4c(const Args& a, Frame& F) {
    int it = F.vcu;
    for (; it < 256; it += F.G) p4c_ssd(a, F, it);
    if (it < 1280) {
        GlaStage S; gla_stage_load(S, a, F, it - 256);
        for (; it < 1280; it += F.G) p4c_gla(a, F, it - 256, S, (it + F.G < 1280) ? it + F.G - 256 : -1); }
}
__device__ __forceinline__ void phase6(const Args& a, Frame& F) {
    const float* X1 = a.out; const float* g2 = a.in[16]; const float* wr = a.in[17]; const float* br = a.in[18]; const float* mod = (const float*)(a.ws + WS_MOD);
    bf16* H2 = (bf16*)(a.ws + WS_H2); unsigned* cntw = (unsigned*)(a.ws + WS_CTL) + CW_CNT; unsigned* list = (unsigned*)(a.ws + WS_LIST);
    const int gw = F.vcu * 8 + F.wave, NGW = F.G * 8;
    LAS float* wl = (LAS float*)F.lds;
    LAS unsigned* lcnt = (LAS unsigned*)(F.lds + 147456);
    LAS unsigned* lbase = lcnt + 32; LAS unsigned* lent = lcnt + 64; LAS unsigned* ltok = lent + 1024;
    if (F.tid < 32) lcnt[F.tid] = 0u;
    const int nmax = (T + NGW - 1) / NGW;
    for (int s = F.tid; s < nmax * 32; s += 512) lent[s] = 0xffffffffu;
    int nloc = 0;
#pragma unroll 4
    for (int i = F.tid; i < 8192; i += 512) { const int d = i >> 3, q = i & 7, pd = (d & ~255) + 64 * (d & 3) + ((d >> 2) & 63); *(LAS f32x4*)(wl + pd * WR_STRIDE + 4 * q) = *(const f32x4*)(wr + d * 32 + 4 * q); }
    __syncthreads();
    float Gm[16], Sh[16]; int bprev = -1;
    f32x4 nx[4];
    if (gw < T) {
#pragma unroll
        for (int j = 0; j < 4; ++j) nx[j] = *(const f32x4*)(X1 + (size_t)gw * D + 256 * j + 4 * F.lane); }
    for (int m = gw; m < T; m += NGW) {
        const int b = m / SEQ; float hv[16]; float ss = 0.f;
#pragma unroll
        for (int j = 0; j < 4; ++j) { hv[4 * j] = nx[j].x; hv[4 * j + 1] = nx[j].y; hv[4 * j + 2] = nx[j].z; hv[4 * j + 3] = nx[j].w; }
        if (m + NGW < T) {
#pragma unroll
            for (int j = 0; j < 4; ++j) nx[j] = *(const f32x4*)(X1 + (size_t)(m + NGW) * D + 256 * j + 4 * F.lane); }
        if (b != bprev) { bprev = b;
#pragma unroll
            for (int jj = 0; jj < 16; ++jj) { const int d = 256 * (jj >> 2) + 4 * F.lane + (jj & 3); Gm[jj] = g2[d] * (1.f + mod[b * 6144 + 4096 + d]); Sh[jj] = mod[b * 6144 + 3072 + d]; } }
#pragma unroll
        for (int jj = 0; jj < 16; ++jj) ss += hv[jj] * hv[jj];
        const float rstd = 1.f / sqrtf(wave_sum(ss) * (1.f / D) + EPS);
#pragma unroll
        for (int jj = 0; jj < 16; ++jj) hv[jj] = hv[jj] * rstd * Gm[jj] + Sh[jj];
#pragma unroll
        for (int j = 0; j < 4; ++j) {
            if (MOE_FP8) *(unsigned*)((unsigned char*)H2 + (size_t)m * D + 256 * j + 4 * F.lane) = pk4_fp8(hv[4 * j], hv[4 * j + 1], hv[4 * j + 2], hv[4 * j + 3]);
            else *(v2u*)(H2 + (size_t)m * D + 256 * j + 4 * F.lane) = (v2u){pk2(hv[4 * j], hv[4 * j + 1]), pk2(hv[4 * j + 2], hv[4 * j + 3])}; }
        float acc[32];
#pragma unroll
        for (int e = 0; e < 32; ++e) acc[e] = 0.f;
#pragma unroll
        for (int jj = 0; jj < 16; ++jj) { const int pd = 256 * (jj >> 2) + 64 * (jj & 3) + F.lane; const LAS f32x4* wp = (const LAS f32x4*)(wl + pd * WR_STRIDE); const float h = hv[jj];
#pragma unroll
            for (int q = 0; q < 8; ++q) { const f32x4 w = wp[q]; acc[4 * q] += h * w.x; acc[4 * q + 1] += h * w.y; acc[4 * q + 2] += h * w.z; acc[4 * q + 3] += h * w.w; }
            if (jj & 1) asm volatile("" ::: "memory"); }
#pragma unroll
        for (int e = 0; e < 32; ++e) acc[e] += __shfl_xor(acc[e], 32);
        { const bool hi = (F.lane & 16) != 0;
#pragma unroll
          for (int i = 0; i < 16; ++i) { const float send = hi ? acc[i] : acc[i + 16], keep = hi ? acc[i + 16] : acc[i]; acc[i] = keep + __shfl_xor(send, 16); } }
        { const bool hi = (F.lane & 8) != 0;
#pragma unroll
          for (int i = 0; i < 8; ++i) { const float send = hi ? acc[i] : acc[i + 8], keep = hi ? acc[i + 8] : acc[i]; acc[i] = keep + __shfl_xor(send, 8); } }
        { const bool hi = (F.lane & 4) != 0;
#pragma unroll
          for (int i = 0; i < 4; ++i) { const float send = hi ? acc[i] : acc[i + 4], keep = hi ? acc[i + 4] : acc[i]; acc[i] = keep + __shfl_xor(send, 4); } }
        { const bool hi = (F.lane & 2) != 0;
#pragma unroll
          for (int i = 0; i < 2; ++i) { const float send = hi ? acc[i] : acc[i + 2], keep = hi ? acc[i + 2] : acc[i]; acc[i] = keep + __shfl_xor(send, 2); } }
        { const bool hi = (F.lane & 1) != 0; const float send = hi ? acc[0] : acc[1], keep = hi ? acc[1] : acc[0]; acc[0] = keep + __shfl_xor(send, 1); }
        const int e_me = F.lane & 31;
        float lv = acc[0] + br[e_me];
        float tv[4]; int ti[4];
#pragma unroll
        for (int k = 0; k < 4; ++k) {
            float mx = lv;
#pragma unroll
            for (int o = 1; o < 32; o <<= 1) mx = fmaxf(mx, __shfl_xor(mx, o));
            const unsigned long long bal = __ballot(lv == mx) & 0xffffffffull;
            const int idx = __builtin_ctzll(bal);
            tv[k] = mx; ti[k] = idx;
            if (e_me == idx) lv = -3.0e38f;
        }
        const float e1 = __expf(tv[1] - tv[0]), e2 = __expf(tv[2] - tv[0]), e3 = __expf(tv[3] - tv[0]); const float inv = 1.f / (1.f + e1 + e2 + e3);
        if (F.lane < 4) {
            const int k = F.lane; const int e = (k == 0) ? ti[0] : (k == 1) ? ti[1] : (k == 2) ? ti[2] : ti[3];
            const float w = ((k == 0) ? 1.f : (k == 1) ? e1 : (k == 2) ? e2 : e3) * inv;
            const unsigned lr = __hip_atomic_fetch_add(&lcnt[e], 1u, __ATOMIC_RELAXED, __HIP_MEMORY_SCOPE_WORKGROUP);
            const int slot = (nloc * 8 + F.wave) * 4 + k;
            lent[slot] = ((unsigned)e << 24) | lr; ltok[slot] = (unsigned)(m * 4 + k) | ((unsigned)__builtin_bit_cast(unsigned short, (_Float16)w) << 16);
        }
        ++nloc;
    }
    __syncthreads();
    if (F.tid < 32) lbase[F.tid] = atomicAdd(&cntw[F.tid * CNT_STRIDE], lcnt[F.tid]);
    __syncthreads();
    for (int s = F.tid; s < nmax * 32; s += 512) { const unsigned en = lent[s]; if (en != 0xffffffffu) { const unsigned e = en >> 24, lr = en & 0xffffffu; list[e * LCAP + lbase[e] + lr] = ltok[s]; } }
}
__device__ __forceinline__ void phase6b_range(const Args& a, Frame& F, int cw, int ncw) {
    for (int it = cw; it < 96 * 512; it += ncw) {
        const int mat = it >> 9, sub = it & 511, e = mat / 3, kind = mat % 3;
        if (kind == 0) transpose_item_f8(a.in[19] + (size_t)e * 1048576, 1024, 1024, a.ws + w1_off(e), sub, F.lane, MapGU{0});
        else if (kind == 1) transpose_item_f8(a.in[21] + (size_t)e * 1048576, 1024, 1024, a.ws + w1_off(e), sub, F.lane, MapGU{1});
        else transpose_item_f8(a.in[23] + (size_t)e * 1048576, 1024, 1024, a.ws + w2_off(e), sub, F.lane, MapId());
    }
}
__device__ __forceinline__ void phase6b(const Args& a, Frame& F) { phase6b_range(a, F, F.vcu * 8 + F.wave, F.G * 8); }
__device__ __forceinline__ void phase6b_tickets(const Args& a, Frame& F) {
    unsigned* ctr = (unsigned*)(a.ws + WS_CTL) + CW_CVT;
    for (;;) {
        unsigned base = 0u; if (F.lane == 0) base = atomicAdd(ctr, 16u);
        base = (unsigned)__builtin_amdgcn_readfirstlane((int)base);
        if (base >= 96u * 512u) break;
        for (int it = (int)base; it < (int)base + 16; ++it) {
            const int mat = it >> 9, sub = it & 511, e = mat / 3, kind = mat % 3;
            if (kind == 0) transpose_item_f8(a.in[19] + (size_t)e * 1048576, 1024, 1024, a.ws + w1_off(e), sub, F.lane, MapGU{0});
            else if (kind == 1) transpose_item_f8(a.in[21] + (size_t)e * 1048576, 1024, 1024, a.ws + w1_off(e), sub, F.lane, MapGU{1});
            else transpose_item_f8(a.in[23] + (size_t)e * 1048576, 1024, 1024, a.ws + w2_off(e), sub, F.lane, MapId());
        }
    }
}
__device__ __forceinline__ void cvt_stream(const Args& a, Frame& F, int sid0, int stride, int nst) {
    const int w = F.wave, lane = F.lane;
    if (w < 4) {
        unsigned og[8];
#pragma unroll
        for (int i = 0; i < 8; ++i) { const int A = (i * 4 + w) * 1024 + lane * 16, row = A >> 8, lc = ((A >> 4) & 15) ^ (((row >> 3) & 1) << 3); og[i] = (unsigned)(row * 4096 + lc * 16); }
        auto issue = [&](int i, int slot) {
            const int sid = sid0 + stride * (i < nst ? i : nst - 1), r = sid & 127, kb2 = r >> 4, nb = r & 15; int e, kind; cv_mat(sid >> 7, e, kind);
            const float* W = (kind == 0 ? a.in[19] : kind == 1 ? a.in[21] : a.in[23]) + (size_t)e * 1048576;
            const char* src = (const char*)(W + (size_t)kb2 * 128 * 1024 + nb * 64); ldsp sl = F.lds + slot * CV_SLOT;
#pragma unroll
            for (int k = 0; k < 8; ++k) __builtin_amdgcn_global_load_lds((const unsigned*)(src + og[k]), (LAS unsigned*)(sl + (k * 4 + w) * 1024), 16, 0, 2);
        };
        const int a2 = w >> 1, b2 = w & 1, q = lane >> 3, l = lane & 7;
        asm volatile("s_waitcnt vmcnt(0)" ::: "memory");
#pragma unroll
        for (int i = 0; i < CV_DP - 1; ++i) issue(i, i);
        for (int s = 0; s <= nst; ++s) {
            if (s < nst) wait_vm<(CV_DP - 2) * 8>();
            LDS_SYNC();
            if (s == nst) break;
            issue(s + CV_DP - 1, (s + CV_DP - 1) & (CV_DP - 1));
            ldsp sl = F.lds + (s & (CV_DP - 1)) * CV_SLOT; ldsp T = F.lds + CV_T + (s & 1) * CV_TB;
            f32x4 v[8];
#pragma unroll
            for (int jj = 0; jj < 8; ++jj) v[jj] = *(const LAS f32x4*)(sl + (a2 * 64 + 8 * q + jj) * 256 + (((b2 * 8 + l) ^ ((q & 1) << 3)) << 4));
#pragma unroll
            for (int i = 0; i < 4; ++i)
                *(LAS v2u*)(T + (b2 * 32 + 4 * l + i) * 144 + a2 * 64 + 8 * q) = (v2u){pk4_fp8(32.f * v[0][i], 32.f * v[1][i], 32.f * v[2][i], 32.f * v[3][i]), pk4_fp8(32.f * v[4][i], 32.f * v[5][i], 32.f * v[6][i], 32.f * v[7][i])};
        }
        wait_vm<0>();
    } else {
        const int t = F.tid - 256;
        for (int s = 0; s <= nst; ++s) {
            LDS_SYNC();
            if (s > 0) {
                const int sid = sid0 + stride * (s - 1), r = sid & 127, kb2 = r >> 4, nb = r & 15, n0 = nb * 64; int e, kind; cv_mat(sid >> 7, e, kind);
                unsigned char* dst = a.ws + (kind < 2 ? w1_off(e) : w2_off(e)) + (size_t)(kind < 2 ? 256 * (n0 >> 7) + 128 * kind + (n0 & 127) : n0) * 1024 + kb2 * 128;
                ldsp T = F.lds + CV_T + ((s - 1) & 1) * CV_TB;
                v4u d[2];
#pragma unroll
                for (int rr = 0; rr < 2; ++rr) { const int id = t + 256 * rr; d[rr] = *(const LAS v4u*)(T + (id >> 3) * 144 + (id & 7) * 16); }
#pragma unroll
                for (int rr = 0; rr < 2; ++rr) { const int id = t + 256 * rr; *(GAS v4u*)(dst + (size_t)(id >> 3) * 1024 + (id & 7) * 16) = d[rr]; }
            }
        }
    }
    LDS_SYNC();
}
__device__ __forceinline__ int moe_table(const Args& a, Frame& F) {
    LAS int* cnt = (LAS int*)(F.lds + TAB_OFF); LAS int* tstart = cnt + 32;
    const unsigned* cntw = (const unsigned*)(a.ws + WS_CTL) + CW_CNT;
    if (F.tid < 32) cnt[F.tid] = (int)__hip_atomic_load(cntw + F.tid * CNT_STRIDE, RLX_AGENT);
    __syncthreads();
    if (F.tid == 0) { int s = 0; for (int e = 0; e < 32; ++e) { tstart[e] = s; s += (cnt[e] + 255) >> 8; } tstart[32] = s; }
    __syncthreads();
    return tstart[32];
}
__device__ __forceinline__ void phase9(const Args& a, Frame& F, float* XO) {
    float* X = a.out; const bf16* SL = (const bf16*)(a.ws + WS_SLAB); const float* mod = (const float*)(a.ws + WS_MOD); const float* fg = a.in[25];
    const int gw = F.vcu * 8 + F.wave, NGW = F.G * 8;
    f32x4 Gt[4], Fg[4], nx[4]; v2u ns[4][4]; unsigned n8[4][4]; int bprev = -1;
#pragma unroll
    for (int j = 0; j < 4; ++j) Fg[j] = *(const f32x4*)(fg + 4 * F.lane + 256 * j);
    auto ld_row = [&](int m) {
#pragma unroll
        for (int j = 0; j < 4; ++j) { const int d0 = 4 * F.lane + 256 * j; nx[j] = *(const f32x4*)(X + (size_t)m * D + d0);
#pragma unroll
            for (int k = 0; k < 4; ++k) { if (SLAB_FP8) n8[j][k] = *(const unsigned*)((const unsigned char*)SL + ((size_t)m * 4 + k) * 1024 + d0); else ns[j][k] = *(const v2u*)(SL + ((size_t)m * 4 + k) * 1024 + d0); } }
    };
    if (gw < T) ld_row(gw);
    for (int m = gw; m < T; m += NGW) {
        const int b = m / SEQ; f32x4 v[4]; float s = 0.f;
        if (b != bprev) { bprev = b;
#pragma unroll
            for (int j = 0; j < 4; ++j) Gt[j] = *(const f32x4*)(mod + b * 6144 + 5120 + 4 * F.lane + 256 * j); }
#pragma unroll
        for (int j = 0; j < 4; ++j) { f32x4 f = (f32x4){0.f, 0.f, 0.f, 0.f};
#pragma unroll
            for (int k = 0; k < 4; ++k) {
                if (SLAB_FP8) { const int w8 = (int)n8[j][k]; f.x += __builtin_amdgcn_cvt_f32_fp8(w8, 0); f.y += __builtin_amdgcn_cvt_f32_fp8(w8, 1); f.z += __builtin_amdgcn_cvt_f32_fp8(w8, 2); f.w += __builtin_amdgcn_cvt_f32_fp8(w8, 3); }
                else { const v2u w = ns[j][k]; f.x += bflo(w.x); f.y += bfhi(w.x); f.z += bflo(w.y); f.w += bfhi(w.y); } }
            if (SLAB_FP8) f = f * (1.f / 32.f);
            v[j] = nx[j] + Gt[j] * f; s += (v[j].x * v[j].x + v[j].y * v[j].y) + (v[j].z * v[j].z + v[j].w * v[j].w); }
        if (m + NGW < T) ld_row(m + NGW);
        const float rstd = 1.f / sqrtf(wave_sum(s) * (1.f / D) + EPS);
#pragma unroll
        for (int j = 0; j < 4; ++j) { const int d0 = 4 * F.lane + 256 * j; *(f32x4*)(XO + (size_t)m * D + d0) = v[j] * rstd * Fg[j]; }
    }
}

#define PRB_KREP_IN 1
#define PRB_EPIREP_IN 1
#define PRB_KREP_GU 1
#define PRB_EPIREP_GU 1
#define PRB_KREP_DN 1
#define PRB_EPIREP_DN 1
#define PHASE_LIST X(0) X(1) X(2) X(3) X(17) X(6) X(7) X(8) X(9) X(10) X(11)
#define X(p) +1
constexpr int NPHASE = 0 PHASE_LIST;
#undef X
template <int PH> __device__ __forceinline__ void run_phase(const Args& args, Frame& F) {
    if constexpr (PH == 0) phase0(args, F);
    else if constexpr (PH == 1) phase1(args, F);
    else if constexpr (PH == 2) {
        DenseSched S{T / 256, NIN / 256, F.G, F.vcu, 2048, (const char*)(args.ws + WS_WIN)};
        EpiProj E{(bf16*)(args.ws + WS_PROJ)};
        pg8::gemm_phase<EpiProj, DenseSched, false, true, true, PRB_KREP_IN, PRB_EPIREP_IN>(F.lds, (const char*)(args.ws + WS_H), 2048, S, E);
        { const int nun = (T / 256) * (NIN / 256), full = nun / F.G, rem = nun - full * F.G;
          if (rem > 0 && F.vcu >= rem && F.vcu - rem < CV_EARLY_WGS && F.G - rem >= CV_EARLY_WGS) cvt_stream(args, F, F.vcu - rem, CV_EARLY_WGS, CV_EARLY_STEPS);
          else if (!(rem > 0 && F.G - rem >= CV_EARLY_WGS) && F.vcu < CV_EARLY_WGS) cvt_stream(args, F, F.vcu, CV_EARLY_WGS, CV_EARLY_STEPS); }
    }
    else if constexpr (PH == 3) phase3(args, F);
    else if constexpr (PH == 4) phase4a(args, F);
    else if constexpr (PH == 5) p4b_scan(args, F);
    else if constexpr (PH == 6) phase4c(args, F);
    else if constexpr (PH == 7) {
        DenseSched S{T / 256, D / 256, F.G, F.vcu, 4096, (const char*)(args.ws + WS_WOUT)};
        EpiRes E{args.in[0], args.out, (const float*)(args.ws + WS_MOD)};
        pg8::gemm_phase(F.lds, (const char*)(args.ws + WS_MIX), 4096, S, E);
    }
    else if constexpr (PH == 8) phase6(args, F);
    else if constexpr (PH == 9) {
        const int ntiles = moe_table(args, F);
        const LAS int* cnt = (const LAS int*)(F.lds + TAB_OFF);
        LAS int* toks = (LAS int*)(F.lds + RING_BYTES + 4096);
        moe_tokens(toks, 8, F.G, F.vcu, ntiles, cnt, cnt + 32, (const unsigned*)(args.ws + WS_LIST), F.tid);
        constexpr int EB = MOE_FP8 ? 1 : 2;
        MoeSched<true> S{8, F.G, F.vcu, 1024 * EB, ntiles, cnt, cnt + 32, toks, (const char*)args.ws, 1};
        LAS float* ept = (LAS float*)(F.lds + EPT_OFF);
        moe_epi_gateup(ept, 8, F.G, F.vcu, ntiles, cnt + 32, args.in[20], args.in[22], F.tid);
        EpiGateUp E{(bf16*)(args.ws + WS_ACT), ept};
        pg8::gemm_phase<EpiGateUp, MoeSched<true>, MOE_FP8 != 0, true, true, PRB_KREP_GU, PRB_EPIREP_GU>(F.lds, (const char*)(args.ws + WS_H2), 1024 * EB, S, E);
    }
    else if constexpr (PH == 10) {
        const int ntiles = moe_table(args, F);
        const LAS int* cnt = (const LAS int*)(F.lds + TAB_OFF);
        constexpr int EB = MOE_FP8 ? 1 : 2;
        MoeSched<false> S{4, F.G, F.vcu, 1024 * EB, ntiles, cnt, cnt + 32, nullptr, (const char*)args.ws, 2};
        LAS unsigned* ept = (LAS unsigned*)(F.lds + EPT_OFF);
        moe_epi_down(ept, 4, F.G, F.vcu, ntiles, cnt, cnt + 32, (const unsigned*)(args.ws + WS_LIST), args.in[24], F.tid);
        EpiDown E{(bf16*)(args.ws + WS_SLAB), ept};
        pg8::gemm_phase<EpiDown, MoeSched<false>, MOE_FP8 != 0, true, true, PRB_KREP_DN, PRB_EPIREP_DN>(F.lds, (const char*)(args.ws + WS_ACT), 1024 * EB, S, E);
    }
    else if constexpr (PH == 12) phase6b(args, F);
    else if constexpr (PH == 17) phase_states(args, F);
    else if constexpr (PH == 13) phase9(args, F, (float*)(args.ws + 1 * MiB));
    else if constexpr (PH == 14) { if (F.vcu == 0 && F.tid < 32) ((unsigned*)(args.ws + WS_CTL))[CW_CNT + F.tid * CNT_STRIDE] = 0u; }
    else phase9(args, F, args.out);
}
__global__ void __launch_bounds__(512, 2) mk_fwd(Args args) {
    extern __shared__ __attribute__((aligned(16))) unsigned char lds_raw[];
    Frame F; F.lds = (LAS unsigned char*)lds_raw; F.tid = threadIdx.x; F.lane = F.tid & 63; F.wave = __builtin_amdgcn_readfirstlane(F.tid >> 6);
    F.G = gridDim.x; { const int bx = blockIdx.x; F.vcu = (F.G % 8 == 0) ? (bx % 8) * (F.G / 8) + bx / 8 : bx; }
    volatile LAS unsigned* MISC = (volatile LAS unsigned*)(F.lds + MISC_OFF);
    if (F.tid < 32) MISC[F.tid] = 0u;
    __syncthreads();
    unsigned* ctl = (unsigned*)(args.ws + WS_CTL);
    XcdBarrier bar; bar.bar = ctl + CW_BAR; bar.x = 0; bar.st = nullptr;
    if (MK_N_LAUNCHES == 1) bar = xcd_barrier_post(ctl + CW_BAR, MISC + 8);
    const int lo = args.ph_lo, hi = args.ph_hi; int idx = 0;
#define X(p) { if (lo <= idx && idx < hi) run_phase<p>(args, F); if (lo <= idx && idx + 1 < hi) xcd_barrier(bar); ++idx; }
    PHASE_LIST
#undef X
}

extern "C" void kernel_launch(void* const* d_in, const int* in_sizes, int n_in, void* d_out, int out_size, void* d_ws, size_t ws_size, hipStream_t stream) {
    static int grid = 0;
    if (grid == 0) {
        if (n_in != 26 || out_size != T * D || ws_size < WS_END) { fprintf(stderr, "kernel_launch: unexpected shapes (n_in %d out %d ws %zu)\n", n_in, out_size, ws_size); grid = -1; return; }
        int dev = 0, cus = 0, per_cu = 0;
        if (hipGetDevice(&dev) != hipSuccess || hipDeviceGetAttribute(&cus, hipDeviceAttributeMultiprocessorCount, dev) != hipSuccess) { grid = -1; return; }
        if (hipFuncSetAttribute((const void*)mk_fwd, hipFuncAttributeMaxDynamicSharedMemorySize, LDS_BYTES) != hipSuccess) { fprintf(stderr, "kernel_launch: hipFuncSetAttribute failed\n"); grid = -1; return; }
        if (hipOccupancyMaxActiveBlocksPerMultiprocessor(&per_cu, (const void*)mk_fwd, 512, LDS_BYTES) != hipSuccess || per_cu < 1) { fprintf(stderr, "kernel_launch: occupancy query says %d\n", per_cu); per_cu = 1; }
        (void)hipGetLastError();
        grid = cus;
    }
    if (grid < 0) return;
    (void)hipMemsetAsync((char*)d_ws + WS_CTL, 0, CTL_ZERO_BYTES, stream);
    Args a{};
    for (int i = 0; i < 26; ++i) a.in[i] = (const float*)d_in[i];
    a.out = (float*)d_out; a.ws = (unsigned char*)d_ws;
    if (MK_N_LAUNCHES == 1) { a.ph_lo = 0; a.ph_hi = NPHASE; hipLaunchKernelGGL(mk_fwd, dim3(grid), dim3(512), LDS_BYTES, stream, a); }
    else { for (int p = 0; p < NPHASE; ++p) { a.ph_lo = p; a.ph_hi = p + 1; hipLaunchKernelGGL(mk_fwd, dim3(grid), dim3(512), LDS_BYTES, stream, a); } }
}
```

```cpp
#include <hip/hip_runtime.h>
#include <cstdio>

#ifndef MK_N_LAUNCHES
#define MK_N_LAUNCHES 1
#endif

#ifndef SLAB_FP8
#define SLAB_FP8 1
#endif
#ifndef MOE_FP8
#define MOE_FP8 1
#endif
#define GAS __attribute__((address_space(1)))
#define LAS __attribute__((address_space(3)))
typedef unsigned short bf16;
typedef unsigned v4u __attribute__((ext_vector_type(4)));
typedef unsigned v2u __attribute__((ext_vector_type(2)));
typedef float f32x4 __attribute__((ext_vector_type(4)));
typedef short bf16x8 __attribute__((ext_vector_type(8)));
typedef int v4i __attribute__((ext_vector_type(4)));
typedef int v8i __attribute__((ext_vector_type(8)));
#define RLX_AGENT __ATOMIC_RELAXED, __HIP_MEMORY_SCOPE_AGENT
#define LDS_WAIT() asm volatile("s_waitcnt lgkmcnt(0)" ::: "memory")
#define VM_WAIT() asm volatile("s_waitcnt vmcnt(0)" ::: "memory")

constexpr int NB = 4, SEQ = 4096, T = NB * SEQ, D = 1024;
constexpr int NIN = 5888;
constexpr int PZ = 0, PX = 1024, PBM = 2048, PCM = 2304, PQ = 2560, PK = 3072, PV = 3584, PR = 4608, PDT = 5632, PGL = 5648;
constexpr int NE = 32, TOPK = 4, LCAP = 16384;
constexpr int MAXTILES = 288;
constexpr float EPS = 1e-6f;

constexpr size_t MiB = 1u << 20;
constexpr size_t WS_CTL = 0, CTL_ZERO_BYTES = 65536;
constexpr size_t WS_MOD = 65536;
constexpr size_t WS_ROWW = 262144;
constexpr size_t WS_WIN = 1 * MiB, WS_WOUT = 13 * MiB;
constexpr size_t WS_H = 17 * MiB;
constexpr size_t WS_PROJ = 49 * MiB;
constexpr size_t WS_GK = 281 * MiB;
constexpr size_t WS_DT = 313 * MiB;
constexpr size_t WS_YPRE = 314 * MiB;
constexpr size_t WS_MIX = 442 * MiB;
constexpr size_t WS_SS = 314 * MiB;
constexpr size_t WS_GS = 346 * MiB;
constexpr size_t WS_SW = 417 * MiB;
constexpr size_t WS_SCD = 418 * MiB;
constexpr size_t WS_KD = 419 * MiB;
constexpr size_t WS_DKL = 435 * MiB;
constexpr size_t WS_CD = 410 * MiB;
constexpr size_t WS_GD = 410 * MiB + 65536;
constexpr size_t WS_H2 = 49 * MiB;
__host__ __device__ constexpr size_t w1_off(int e) { return (e < 24 ? (size_t)(233 + 2 * e) : (size_t)(17 + 2 * (e - 24))) * MiB; }
__host__ __device__ constexpr size_t w2_off(int e) { return (e < 16 ? (size_t)(33 + e) : e < 28 ? (size_t)(1 + (e - 16)) : (size_t)(411 + (e - 28))) * MiB; }
constexpr size_t WS_ACT = 65 * MiB;
constexpr size_t WS_SLAB = 281 * MiB;
constexpr size_t WS_LIST = 415 * MiB;
constexpr size_t WS_END = 506 * MiB;
constexpr int CW_BAR = 1024;
constexpr int CW_CVT = 6144;
constexpr int CW_CNT = 8192, CNT_STRIDE = 128;

constexpr int RING_BYTES = 131072;
constexpr int LDS_BYTES = 163840;
constexpr int TAB_OFF = LDS_BYTES - 1024;
constexpr int MISC_OFF = LDS_BYTES - 256;
constexpr int WR_STRIDE = 36;

typedef __bf16 bf16x2_t __attribute__((ext_vector_type(2)));
typedef float f32x2_t __attribute__((ext_vector_type(2)));
__device__ __forceinline__ unsigned pk2(float lo, float hi) { const f32x2_t v = {lo, hi}; return __builtin_bit_cast(unsigned, __builtin_convertvector(v, bf16x2_t)); }
__device__ __forceinline__ unsigned f2bf(float f) { return pk2(f, f) & 0xffffu; }
__device__ __forceinline__ float bf2f(unsigned b) { return __builtin_bit_cast(float, b << 16); }
__device__ __forceinline__ float bflo(unsigned w) { return __builtin_bit_cast(float, w << 16); }
__device__ __forceinline__ float bfhi(unsigned w) { return __builtin_bit_cast(float, w & 0xffff0000u); }
__device__ __forceinline__ unsigned pk4_fp8(float a, float b, float c, float d) { int p = __builtin_amdgcn_cvt_pk_fp8_f32(a, b, 0, false); p = __builtin_amdgcn_cvt_pk_fp8_f32(c, d, p, true); return (unsigned)p; }
__device__ __forceinline__ float wave_sum(float v) {
#pragma unroll
    for (int o = 1; o < 64; o <<= 1) v += __shfl_xor(v, o);
    return v;
}
__device__ __forceinline__ float silu_f(float x) { return x * __builtin_amdgcn_rcpf(1.f + __expf(-x)); }
__device__ __forceinline__ float softplus_f(float x) { return fmaxf(x, 0.f) + __logf(1.f + __expf(-fabsf(x))); }
__device__ __forceinline__ float logsigmoid_f(float x) { return fminf(x, 0.f) - __logf(1.f + __expf(-fabsf(x))); }

#define XB_TMO      128
#define XB_XCNT(j)  (256  + 64 * (j))
#define XB_XSUB(j)  (1280 + 64 * (j))
#define XB_XGEN(j)  (2304 + 64 * (j))
#define XB_TOP      3328
#define XB_TOPGEN   3392
#define XCD_BAR_WORDS 3456
#define XB_SPIN_CAP (1u << 21)
__device__ __forceinline__ unsigned xb_ld(unsigned* p)              { return __hip_atomic_load(p, __ATOMIC_RELAXED, __HIP_MEMORY_SCOPE_AGENT); }
__device__ __forceinline__ unsigned xb_add(unsigned* p, unsigned v) { return __hip_atomic_fetch_add(p, v, __ATOMIC_RELAXED, __HIP_MEMORY_SCOPE_AGENT); }
__device__ __forceinline__ unsigned xb_xcc_id() { return (unsigned)__builtin_amdgcn_s_getreg((3 << 11) | 20) & 0xFu; }
#define XB_SPIN(cond, bar) do { unsigned _sp = 0; while (cond) { __builtin_amdgcn_s_sleep(1); \
    if ((++_sp & 255u) == 0u) { if (xb_ld(&(bar)[XB_TMO])) break; if (_sp > XB_SPIN_CAP) { atomicAdd(&(bar)[XB_TMO], 1u); break; } } } } while (0)
struct XcdBarrier { unsigned* bar; unsigned x; volatile LAS unsigned* st; };
__device__ __forceinline__ XcdBarrier xcd_barrier_post(unsigned* bar, volatile LAS unsigned* st) {
    XcdBarrier b; b.bar = bar; b.x = xb_xcc_id(); b.st = st;
    if (threadIdx.x == 0) (void)xb_add(&bar[XB_XCNT(b.x)], 1u);
    return b;
}
__device__ __forceinline__ void xcd_barrier_complete(unsigned* bar, unsigned x, unsigned& nloc, unsigned& nx) {
    const unsigned G = gridDim.x * gridDim.y * gridDim.z;
    unsigned sum, cnt, mine, sp = 0u;
    for (;;) {
        sum = 0u; cnt = 0u; mine = 0u;
#pragma unroll
        for (unsigned j = 0; j < 16; ++j) { const unsigned c = xb_ld(&bar[XB_XCNT(j)]); sum += c; cnt += (c > 0u) ? 1u : 0u; mine = (j == x) ? c : mine; }
        if (sum == G) break;
        __builtin_amdgcn_s_sleep(1);
        if ((++sp & 255u) == 0u) { if (xb_ld(&bar[XB_TMO])) break; if (sp > XB_SPIN_CAP) { atomicAdd(&bar[XB_TMO], 1u); break; } }
    }
    nloc = mine > 0u ? mine : 1u; nx = cnt > 0u ? cnt : 1u;
}
__device__ __forceinline__ void xcd_barrier(const XcdBarrier& b) {
    asm volatile("s_waitcnt vmcnt(0)" ::: "memory");
    __syncthreads();
    if (threadIdx.x == 0) {
        unsigned* bar = b.bar;
        __builtin_amdgcn_s_waitcnt(0);
        unsigned nloc = b.st[0], nx = b.st[1];
        if (nloc == 0u) { xcd_barrier_complete(bar, b.x, nloc, nx); b.st[0] = nloc; b.st[1] = nx; }
        const unsigned old = xb_add(&bar[XB_XSUB(b.x)], 1u);
        const unsigned gen = old / nloc;
        if (old + 1u == (gen + 1u) * nloc) {
            __builtin_amdgcn_fence(__ATOMIC_RELEASE, "agent");
            asm volatile("s_waitcnt vmcnt(0)" ::: "memory");
            const unsigned og = xb_add(&bar[XB_TOP], 1u);
            const unsigned tg = og / nx;
            if (og + 1u == (tg + 1u) * nx) xb_add(&bar[XB_TOPGEN], 1u);
            else XB_SPIN(xb_ld(&bar[XB_TOPGEN]) == tg, bar);
            __builtin_amdgcn_fence(__ATOMIC_ACQUIRE, "agent");
            xb_add(&bar[XB_XGEN(b.x)], 1u);
            asm volatile("s_waitcnt vmcnt(0)" ::: "memory");
        } else {
            XB_SPIN(xb_ld(&bar[XB_XGEN(b.x)]) == gen, bar);
            __builtin_amdgcn_fence(__ATOMIC_ACQUIRE, "agent");
            asm volatile("s_waitcnt vmcnt(0)" ::: "memory");
        }
    }
    __syncthreads();
}

namespace pg8 {
constexpr int BM = 256, BK = 64, HALF = 128, HTB = HALF * BK * 2, STAGE_BYTES = 8 * HTB;
__device__ __forceinline__ int lds_byte(int r, int c) { const int st = (r >> 4) * 2 + (c >> 5), rr = r & 15, cc = c & 31, ob = rr * 64 + cc * 2; return st * 1024 + (ob ^ (((ob >> 9) & 1) << 5)); }
__device__ __forceinline__ void stage_rc(int b, int& R, int& C) { const int st = b / 1024, sb = b % 1024, swz = sb ^ (((sb >> 9) & 1) << 5); R = (st >> 1) * 16 + swz / 64; C = (st & 1) * 32 + (swz % 64) / 2; }
__device__ __forceinline__ int perm32(int rho) { const int n = rho >> 4, i = rho & 15; return 8 * (i >> 2) + 4 * n + (i & 3); }
struct Unit { int pm, pn, e, pos0, slot; };

__device__ __forceinline__ v8i cat8(bf16x8 lo, bf16x8 hi) { return __builtin_shufflevector(__builtin_bit_cast(v4i, lo), __builtin_bit_cast(v4i, hi), 0, 1, 2, 3, 4, 5, 6, 7); }
__device__ __forceinline__ unsigned cvt_pk_bf16(float lo, float hi) { return pk2(lo, hi); }

template <class Epi, class Sched, bool F8 = false, bool SP2 = true, bool ALIGN_EPI = true, int KREP = 1, int EPIREP = 1>
__device__ __forceinline__ void gemm_phase(LAS unsigned char* lds, const char* Abase, const int rp, const Sched& S, const Epi& E) {
    const int tid = threadIdx.x, wid = __builtin_amdgcn_readfirstlane(tid >> 6), lane = tid & 63, wr = wid >> 2, wc = wid & 3, fr = lane & 15, fq = lane >> 4;
    const int nt = rp / 128;
    int Rr[2], Cb[2]; unsigned voffB[2];
#pragma unroll
    for (int i = 0; i < 2; ++i) { int R, C; stage_rc(tid * 16 + i * 8192, R, C); Rr[i] = R; Cb[i] = C * 2; const int Rb = Epi::PERM ? ((R & ~31) + perm32(R & 31)) : R; voffB[i] = (unsigned)(Rb * rp + C * 2); }
    const size_t kstep = (size_t)(BK * 2);
    const size_t hstep = (size_t)HALF * rp;
    const unsigned ldsw = (unsigned)wid * 1024u;
    const int aoff = lds_byte(wr * 64 + fr, fq * 8), boff = lds_byte(wc * 32 + fr, fq * 8);
#define PG8_SA(b, h) (((b) * 2 + (h)) * HTB)
#define PG8_SB(b, h) ((4 + (b) * 2 + (h)) * HTB)
#define PG8_STAGE(bufoff, gbase, voff) do { _Pragma("unroll") for (int _i = 0; _i < 2; ++_i) \
        __builtin_amdgcn_global_load_lds((const unsigned*)((const char*)(gbase) + (voff)[_i]), (LAS unsigned*)(lds + (bufoff) + ldsw + _i * 8192), 16, 0, 0); } while (0)
#define PG8_LDA(dst, b, h) do { _Pragma("unroll") for (int m = 0; m < 4; ++m) _Pragma("unroll") for (int k = 0; k < 2; ++k) dst[m][k] = *(const LAS bf16x8*)(lds + PG8_SA(b, h) + aoff + m * 2048 + k * 1024); } while (0)
#define PG8_LDB(dst, b, h) do { _Pragma("unroll") for (int n = 0; n < 2; ++n) _Pragma("unroll") for (int k = 0; k < 2; ++k) dst[n][k] = *(const LAS bf16x8*)(lds + PG8_SB(b, h) + boff + n * 2048 + k * 1024); } while (0)
#define PG8_MMA(ai, bj, At, Bt) do { __builtin_amdgcn_s_setprio(1); _Pragma("unroll") for (int m = 0; m < 4; ++m) _Pragma("unroll") for (int n = 0; n < 2; ++n) { \
        if constexpr (F8) asm volatile("v_mfma_scale_f32_16x16x128_f8f6f4 %0, %1, %2, %0, %3, %4 op_sel_hi:[0,0,0]" : "+v"(acc[ai][bj][m][n]) : "v"(cat8(Bt[n][0], Bt[n][1])), "v"(cat8(At[m][0], At[m][1])), "v"(sc_w), "v"(sc_a)); \
        else { _Pragma("unroll") for (int k = 0; k < 2; ++k) acc[ai][bj][m][n] = __builtin_amdgcn_mfma_f32_16x16x32_bf16(Bt[n][k], At[m][k], acc[ai][bj][m][n], 0, 0, 0); } } \
        __builtin_amdgcn_s_setprio(0); } while (0)
#define PG8_WAIT_V(n) asm volatile("s_waitcnt vmcnt(" #n ")" ::: "memory")
#define PG8_WAIT_L(n) asm volatile("s_waitcnt lgkmcnt(" #n ")" ::: "memory")
#define PG8_BAR __builtin_amdgcn_s_barrier()
#define PG8_SCHED __builtin_amdgcn_sched_barrier(0)
    Unit cur, nxt; int ui = 0;
    if (!S.next(0, cur)) return;
    const int sc_w = Epi::SCALE_W, sc_a = 0x7f7f7f7f;
    f32x4 acc[2][2][4][2];
#pragma unroll
    for (int b = 0; b < 2; ++b)
#pragma unroll
        for (int n = 0; n < 2; ++n) { const f32x4 bi = E.bias(cur, b, n, wc, fq);
#pragma unroll
            for (int a = 0; a < 2; ++a)
#pragma unroll
                for (int m = 0; m < 4; ++m) acc[a][b][m][n] = bi; }
    bf16x8 At[4][2], B0[2][2], B1[2][2];
    unsigned ca[2][2];
    S.a_off(cur, Rr, Cb, ca);
    const char* cB = S.b_ptr(cur);
    if constexpr (SP2) {
        PG8_STAGE(PG8_SB(0, 0), cB, voffB); PG8_STAGE(PG8_SB(0, 1), cB + hstep, voffB); PG8_STAGE(PG8_SA(0, 0), Abase, ca[0]); PG8_STAGE(PG8_SA(0, 1), Abase, ca[1]);
        if (wr == 1) PG8_BAR;
        PG8_WAIT_V(2); PG8_BAR;
        PG8_STAGE(PG8_SB(1, 0), cB + kstep, voffB); PG8_STAGE(PG8_SA(1, 0), Abase + kstep, ca[0]); PG8_STAGE(PG8_SB(1, 1), cB + hstep + kstep, voffB);
        PG8_WAIT_V(6); PG8_BAR;
    } else {
        PG8_STAGE(PG8_SB(0, 0), cB, voffB); PG8_STAGE(PG8_SA(0, 0), Abase, ca[0]); PG8_STAGE(PG8_SB(0, 1), cB + hstep, voffB); PG8_STAGE(PG8_SA(0, 1), Abase, ca[1]);
        if (wr == 1) PG8_BAR;
        PG8_WAIT_V(4); PG8_BAR;
        PG8_STAGE(PG8_SB(1, 0), cB + kstep, voffB); PG8_STAGE(PG8_SA(1, 0), Abase + kstep, ca[0]); PG8_STAGE(PG8_SB(1, 1), cB + hstep + kstep, voffB);
        PG8_WAIT_V(6); PG8_BAR;
    }
    for (;;) {
        const bool has_next = S.next(ui + 1, nxt);
        const char* nB = has_next ? S.b_ptr(nxt) : cB;
        for (int t = 0; t < nt * KREP; t += 2) {
            const bool last = (t == nt * KREP - 2);
            const char* a1 = Abase + (size_t)((t + 1) & (nt - 1)) * kstep;
            const char* a2 = last ? Abase : Abase + (size_t)((t + 2) & (nt - 1)) * kstep; const char* b2 = last ? nB : cB + (size_t)((t + 2) & (nt - 1)) * kstep;
            const char* a3 = a2 + kstep; const char* b3 = b2 + kstep;
            unsigned o2[2][2];
#pragma unroll
            for (int h = 0; h < 2; ++h)
#pragma unroll
                for (int i = 0; i < 2; ++i) o2[h][i] = ca[h][i];
            if (last && has_next) S.a_off(nxt, Rr, Cb, o2);
            if constexpr (SP2) {
            PG8_LDB(B0, 0, 0); PG8_LDB(B1, 0, 1); PG8_SCHED; PG8_LDA(At, 0, 0); PG8_STAGE(PG8_SA(1, 1), a1, ca[1]);
            PG8_WAIT_V(8); PG8_WAIT_L(0); PG8_BAR; PG8_MMA(0, 0, At, B0); PG8_MMA(0, 1, At, B1); PG8_BAR; PG8_SCHED;
            PG8_LDA(At, 0, 1); PG8_STAGE(PG8_SB(0, 0), b2, voffB); PG8_STAGE(PG8_SB(0, 1), b2 + hstep, voffB); PG8_STAGE(PG8_SA(0, 0), a2, o2[0]);
            PG8_WAIT_V(8); PG8_WAIT_L(0); PG8_BAR; PG8_MMA(1, 0, At, B0); PG8_MMA(1, 1, At, B1); PG8_BAR; PG8_SCHED;
            PG8_LDB(B0, 1, 0); PG8_LDB(B1, 1, 1); PG8_SCHED; PG8_LDA(At, 1, 0); PG8_STAGE(PG8_SA(0, 1), a2, o2[1]);
            PG8_WAIT_V(8); PG8_WAIT_L(0); PG8_BAR; PG8_MMA(0, 0, At, B0); PG8_MMA(0, 1, At, B1); PG8_BAR; PG8_SCHED;
            PG8_LDA(At, 1, 1); PG8_STAGE(PG8_SB(1, 0), b3, voffB); PG8_STAGE(PG8_SB(1, 1), b3 + hstep, voffB); PG8_STAGE(PG8_SA(1, 0), a3, o2[0]);
            PG8_WAIT_V(8); PG8_WAIT_L(0); PG8_BAR; PG8_MMA(1, 0, At, B0); PG8_MMA(1, 1, At, B1); PG8_BAR; PG8_SCHED;
            } else {
            PG8_LDB(B0, 0, 0); PG8_SCHED; PG8_LDA(At, 0, 0); PG8_STAGE(PG8_SA(1, 1), a1, ca[1]);
            PG8_WAIT_L(8); PG8_BAR; PG8_WAIT_L(0); PG8_MMA(0, 0, At, B0); PG8_BAR; PG8_SCHED;
            PG8_LDB(B1, 0, 1); PG8_STAGE(PG8_SB(0, 0), b2, voffB);
            PG8_BAR; PG8_WAIT_L(0); PG8_MMA(0, 1, At, B1); PG8_BAR;
            PG8_LDA(At, 0, 1); PG8_STAGE(PG8_SA(0, 0), a2, o2[0]);
            PG8_BAR; PG8_WAIT_L(0); PG8_MMA(1, 0, At, B0); PG8_BAR; PG8_SCHED;
            PG8_STAGE(PG8_SB(0, 1), b2 + hstep, voffB);
            PG8_WAIT_V(6); PG8_BAR; PG8_MMA(1, 1, At, B1); PG8_BAR;
            PG8_LDB(B0, 1, 0); PG8_SCHED; PG8_LDA(At, 1, 0); PG8_STAGE(PG8_SA(0, 1), a2, o2[1]);
            PG8_WAIT_L(8); PG8_BAR; PG8_WAIT_L(0); PG8_MMA(0, 0, At, B0); PG8_BAR; PG8_SCHED;
            PG8_LDB(B1, 1, 1); PG8_STAGE(PG8_SB(1, 0), b3, voffB);
            PG8_BAR; PG8_WAIT_L(0); PG8_MMA(0, 1, At, B1); PG8_BAR;
            PG8_LDA(At, 1, 1); PG8_STAGE(PG8_SA(1, 0), a3, o2[0]);
            PG8_BAR; PG8_WAIT_L(0); PG8_MMA(1, 0, At, B0); PG8_BAR; PG8_SCHED;
            PG8_STAGE(PG8_SB(1, 1), b3 + hstep, voffB);
            PG8_WAIT_V(6); PG8_BAR; PG8_MMA(1, 1, At, B1); PG8_BAR;
            }
        }
        if constexpr (ALIGN_EPI) { if (wr == 0) PG8_BAR; }
        if constexpr (F8) asm volatile("s_nop 15\n\ts_nop 15" ::: "memory");
        if constexpr (KREP > 1) {
#pragma unroll
            for (int a = 0; a < 2; ++a)
#pragma unroll
                for (int b = 0; b < 2; ++b)
#pragma unroll
                    for (int m = 0; m < 4; ++m)
#pragma unroll
                        for (int n = 0; n < 2; ++n) acc[a][b][m][n] *= (1.f / KREP);
        }
#pragma unroll 1
        for (int er = 0; er < EPIREP; ++er) { E(acc, cur, wr, wc, fr, fq); asm volatile("" ::: "memory"); }
        if (!has_next) break;
#pragma unroll
        for (int b = 0; b < 2; ++b)
#pragma unroll
            for (int n = 0; n < 2; ++n) { const f32x4 bi = E.bias(nxt, b, n, wc, fq);
#pragma unroll
                for (int a = 0; a < 2; ++a)
#pragma unroll
                    for (int m = 0; m < 4; ++m) acc[a][b][m][n] = bi; }
        cur = nxt; cB = nB; ++ui;
        if constexpr (ALIGN_EPI) { if (wr == 1) PG8_BAR; }
        S.a_off(cur, Rr, Cb, ca);
    }
    PG8_WAIT_V(0);
    if constexpr (!ALIGN_EPI) { if (wr == 0) PG8_BAR; }
    PG8_BAR;
#undef PG8_SA
#undef PG8_SB
#undef PG8_STAGE
#undef PG8_LDA
#undef PG8_LDB
#undef PG8_MMA
#undef PG8_WAIT_V
#undef PG8_WAIT_L
#undef PG8_BAR
#undef PG8_SCHED
}
}

struct DenseSched {
    static constexpr bool GATHER = false;
    int nM, nN, G, vcu, pitch; const char* Bt;
    __device__ __forceinline__ bool next(int i, pg8::Unit& u) const {
        const int L = i * G + vcu; if (L >= nM * nN) return false;
        const int nig = 8 * nN, gid = L / nig, r = L % nig, fm = gid * 8, gsz = (nM - fm) < 8 ? (nM - fm) : 8;
        u.pm = fm + r % gsz; u.pn = r / gsz; u.e = 0; u.pos0 = 0; u.slot = i; return true;
    }
    __device__ __forceinline__ void a_off(const pg8::Unit& u, const int (&R)[2], const int (&Cb)[2], unsigned (&off)[2][2]) const {
#pragma unroll
        for (int h = 0; h < 2; ++h)
#pragma unroll
            for (int i = 0; i < 2; ++i) off[h][i] = (unsigned)((u.pm * 256 + h * 128 + R[i]) * pitch) + (unsigned)Cb[i];
    }
    __device__ __forceinline__ const char* b_ptr(const pg8::Unit& u) const { return Bt + (size_t)u.pn * 256 * pitch; }
};
template <bool GATHER_> struct MoeSched {
    static constexpr bool GATHER = GATHER_;
    int nN, G, vcu, pitch, ntiles; const LAS int* cnt; const LAS int* tstart; const LAS int* toks; const char* wsb; int which;
    __device__ __forceinline__ bool next(int i, pg8::Unit& u) const {
        const int L = i * G + vcu; if (L >= ntiles * nN) return false;
        const int pm = L / nN; int e = 0;
        for (int j = 1; j < NE; ++j) e += (tstart[j] <= pm) ? 1 : 0;
        u.pm = __builtin_amdgcn_readfirstlane(pm); u.pn = __builtin_amdgcn_readfirstlane(L % nN); u.e = __builtin_amdgcn_readfirstlane(e);
        u.pos0 = __builtin_amdgcn_readfirstlane((pm - tstart[e]) * 256); u.slot = i; return true;
    }
    __device__ __forceinline__ void a_off(const pg8::Unit& u, const int (&R)[2], const int (&Cb)[2], unsigned (&off)[2][2]) const {
#pragma unroll
        for (int h = 0; h < 2; ++h)
#pragma unroll
            for (int i = 0; i < 2; ++i) {
                if (GATHER) off[h][i] = (unsigned)toks[u.slot * 256 + h * 128 + R[i]] * (unsigned)pitch + (unsigned)Cb[i];
                else off[h][i] = (unsigned)((u.pm * 256 + h * 128 + R[i]) * pitch) + (unsigned)Cb[i];
            }
    }
    __device__ __forceinline__ const char* b_ptr(const pg8::Unit& u) const { return wsb + (which == 1 ? w1_off(u.e) : w2_off(u.e)) + (size_t)u.pn * 256 * pitch; }
};
__device__ __forceinline__ void moe_tokens(LAS int* toks, int nN, int G, int vcu, int ntiles, const LAS int* cnt, const LAS int* tstart, const unsigned* list, int tid) {
    for (int i = 0; i < 12; ++i) { const int L = i * G + vcu; if (L >= ntiles * nN) break;
        const int pm = L / nN; int e = 0;
        for (int j = 1; j < NE; ++j) e += (tstart[j] <= pm) ? 1 : 0;
        const int pos = (pm - tstart[e]) * 256 + tid;
        if (tid < 256) toks[i * 256 + tid] = (pos < cnt[e]) ? (int)((list[e * LCAP + pos] & 0xffffu) >> 2) : 0; }
    __syncthreads();
}

constexpr int EPT_OFF = RING_BYTES + 4096 + 12288;
__device__ __forceinline__ void moe_epi_gateup(LAS float* tab, int nN, int G, int vcu, int ntiles, const LAS int* tstart, const float* bg, const float* bu, int tid) {
    for (int i = 0; i < 12; ++i) { const int L = i * G + vcu; if (L >= ntiles * nN) break;
        const int pm = L / nN, pn = L % nN; int e = 0;
        for (int j = 1; j < NE; ++j) e += (tstart[j] <= pm) ? 1 : 0;
        if (tid < 256) { const int j = tid & 127; tab[i * 256 + tid] = (tid < 128) ? bg[e * 1024 + pn * 128 + j] : bu[e * 1024 + pn * 128 + j] + 1.f; } }
    __syncthreads();
}
__device__ __forceinline__ void moe_epi_down(LAS unsigned* tab, int nN, int G, int vcu, int ntiles, const LAS int* cnt, const LAS int* tstart, const unsigned* list, const float* bd, int tid) {
    for (int i = 0; i < 6; ++i) { const int L = i * G + vcu; if (L >= ntiles * nN) break;
        const int pm = L / nN, pn = L % nN; int e = 0;
        for (int j = 1; j < NE; ++j) e += (tstart[j] <= pm) ? 1 : 0;
        const int pos = (pm - tstart[e]) * 256 + tid;
        if (tid < 256) tab[i * 512 + tid] = (pos < cnt[e]) ? list[e * LCAP + pos] : 0xffffffffu;
        else tab[i * 512 + tid] = __builtin_bit_cast(unsigned, bd[e * 1024 + pn * 256 + tid - 256]); }
    __syncthreads();
}
struct EpiProj {
    static constexpr bool PERM = true; static constexpr int SCALE_W = 0x7f7f7f7f;
    bf16* O;
    __device__ __forceinline__ f32x4 bias(const pg8::Unit&, int, int, int, int) const { return (f32x4){0.f, 0.f, 0.f, 0.f}; }
    __device__ __forceinline__ void operator()(const f32x4 (&acc)[2][2][4][2], const pg8::Unit& u, int wr, int wc, int fr, int fq) const {
        const int row0 = u.pm * 256 + wr * 64 + fr, col0 = u.pn * 256 + wc * 32 + 8 * fq;
#pragma unroll
        for (int ai = 0; ai < 2; ++ai)
#pragma unroll
            for (int m = 0; m < 4; ++m) { bf16* rowp = O + (size_t)(row0 + ai * 128 + m * 16) * NIN + col0;
#pragma unroll
                for (int bj = 0; bj < 2; ++bj) { const f32x4 v0 = acc[ai][bj][m][0], v1 = acc[ai][bj][m][1];
                    v4u w; w.x = pg8::cvt_pk_bf16(v0[0], v0[1]); w.y = pg8::cvt_pk_bf16(v0[2], v0[3]); w.z = pg8::cvt_pk_bf16(v1[0], v1[1]); w.w = pg8::cvt_pk_bf16(v1[2], v1[3]);
                    *(v4u*)(rowp + bj * 128) = w; } }
    }
};
struct EpiRes {
    static constexpr bool PERM = false; static constexpr int SCALE_W = 0x7f7f7f7f;
    const float* x; float* out; const float* mod;
    __device__ __forceinline__ f32x4 bias(const pg8::Unit&, int, int, int, int) const { return (f32x4){0.f, 0.f, 0.f, 0.f}; }
    __device__ __forceinline__ void operator()(const f32x4 (&acc)[2][2][4][2], const pg8::Unit& u, int wr, int wc, int fr, int fq) const {
        const int row0 = u.pm * 256 + wr * 64 + fr, col0 = u.pn * 256 + wc * 32 + 4 * fq;
        const int b = (u.pm * 256) / SEQ;
        f32x4 gv[2][2];
#pragma unroll
        for (int bj = 0; bj < 2; ++bj)
#pragma unroll
            for (int n = 0; n < 2; ++n) gv[bj][n] = *(const f32x4*)(mod + b * 6144 + 2048 + col0 + bj * 128 + n * 16);
#pragma unroll
        for (int ai = 0; ai < 2; ++ai)
#pragma unroll
            for (int m = 0; m < 4; ++m) { const size_t off = (size_t)(row0 + ai * 128 + m * 16) * D + col0;
#pragma unroll
                for (int bj = 0; bj < 2; ++bj)
#pragma unroll
                    for (int n = 0; n < 2; ++n) { const f32x4 xv = *(const f32x4*)(x + off + bj * 128 + n * 16); *(f32x4*)(out + off + bj * 128 + n * 16) = xv + gv[bj][n] * acc[ai][bj][m][n]; } }
    }
};
struct EpiGateUp {
    static constexpr bool PERM = true; static constexpr int SCALE_W = 0x7a7a7a7a;
    bf16* act; const LAS float* tab;
    __device__ __forceinline__ f32x4 bias(const pg8::Unit& u, int bj, int n, int wc, int fq) const { return *(const LAS f32x4*)(tab + u.slot * 256 + 128 * bj + wc * 32 + 8 * fq + 4 * n); }
    __device__ __forceinline__ void operator()(const f32x4 (&acc)[2][2][4][2], const pg8::Unit& u, int wr, int wc, int fr, int fq) const {
        const int row0 = u.pm * 256 + wr * 64 + fr, c0 = u.pn * 128 + wc * 32 + 8 * fq;
#pragma unroll
        for (int ai = 0; ai < 2; ++ai)
#pragma unroll
            for (int m = 0; m < 4; ++m) { float o[8];
#pragma unroll
                for (int n = 0; n < 2; ++n) { const f32x4 g4 = acc[ai][0][m][n], u4 = acc[ai][1][m][n];
#pragma unroll
                    for (int jp = 0; jp < 2; ++jp) {
                        f32x2_t g2 = {fminf(g4[2 * jp], 7.f), fminf(g4[2 * jp + 1], 7.f)};
                        const f32x2_t u2 = {__builtin_amdgcn_fmed3f(u4[2 * jp], -6.f, 8.f), __builtin_amdgcn_fmed3f(u4[2 * jp + 1], -6.f, 8.f)};
                        const f32x2_t t2 = g2 * (-1.702f * 1.44269504f);
                        f32x2_t d2 = {__builtin_amdgcn_exp2f(t2.x), __builtin_amdgcn_exp2f(t2.y)}; d2 = d2 + 1.f;
                        const f32x2_t r2 = {__builtin_amdgcn_rcpf(d2.x), __builtin_amdgcn_rcpf(d2.y)};
                        const f32x2_t o2 = (g2 * r2) * u2; o[4 * n + 2 * jp] = o2.x; o[4 * n + 2 * jp + 1] = o2.y; } }
                if (MOE_FP8) *(v2u*)((unsigned char*)act + (size_t)(row0 + ai * 128 + m * 16) * 1024 + c0) = (v2u){pk4_fp8(o[0], o[1], o[2], o[3]), pk4_fp8(o[4], o[5], o[6], o[7])};
                else *(v4u*)(act + (size_t)(row0 + ai * 128 + m * 16) * 1024 + c0) = (v4u){pg8::cvt_pk_bf16(o[0], o[1]), pg8::cvt_pk_bf16(o[2], o[3]), pg8::cvt_pk_bf16(o[4], o[5]), pg8::cvt_pk_bf16(o[6], o[7])}; }
    }
};
struct EpiDown {
    static constexpr bool PERM = true; static constexpr int SCALE_W = 0x7a7a7a7a;
    bf16* slab; const LAS unsigned* tab;
    __device__ __forceinline__ f32x4 bias(const pg8::Unit& u, int bj, int n, int wc, int fq) const { return *(const LAS f32x4*)((const LAS float*)tab + u.slot * 512 + 256 + wc * 32 + 8 * fq + bj * 128 + 4 * n); }
    __device__ __forceinline__ void operator()(const f32x4 (&acc)[2][2][4][2], const pg8::Unit& u, int wr, int wc, int fr, int fq) const {
        const int r0 = wr * 64 + fr, col0 = u.pn * 256 + wc * 32 + 8 * fq;
        unsigned info[2][4];
#pragma unroll
        for (int ai = 0; ai < 2; ++ai)
#pragma unroll
            for (int m = 0; m < 4; ++m) info[ai][m] = tab[u.slot * 512 + r0 + ai * 128 + m * 16];
#pragma unroll
        for (int ai = 0; ai < 2; ++ai)
#pragma unroll
            for (int m = 0; m < 4; ++m) {
                if (info[ai][m] != 0xffffffffu) { const float w = (float)__builtin_bit_cast(_Float16, (unsigned short)(info[ai][m] >> 16)); bf16* rowp = slab + (size_t)(info[ai][m] & 0xffffu) * 1024 + col0;
#pragma unroll
                    for (int bj = 0; bj < 2; ++bj) {
                        if (SLAB_FP8) { const float w32 = w * 32.f; f32x4 v0 = acc[ai][bj][m][0] * w32, v1 = acc[ai][bj][m][1] * w32;
#pragma unroll
                            for (int q = 0; q < 4; ++q) { v0[q] = __builtin_amdgcn_fmed3f(v0[q], -448.f, 448.f); v1[q] = __builtin_amdgcn_fmed3f(v1[q], -448.f, 448.f); }
                            *(v2u*)((unsigned char*)slab + (size_t)(info[ai][m] & 0xffffu) * 1024 + col0 + bj * 128) = (v2u){pk4_fp8(v0[0], v0[1], v0[2], v0[3]), pk4_fp8(v1[0], v1[1], v1[2], v1[3])}; }
                        else { const f32x4 v0 = acc[ai][bj][m][0] * w, v1 = acc[ai][bj][m][1] * w;
                            v4u o; o.x = pg8::cvt_pk_bf16(v0[0], v0[1]); o.y = pg8::cvt_pk_bf16(v0[2], v0[3]); o.z = pg8::cvt_pk_bf16(v1[0], v1[1]); o.w = pg8::cvt_pk_bf16(v1[2], v1[3]);
                            *(v4u*)(rowp + bj * 128) = o; } } } }
    }
};

struct Args { const float* in[26]; float* out; unsigned char* ws; int ph_lo, ph_hi; };
struct Frame { LAS unsigned char* lds; int tid, lane, wave, vcu, G; };

template <class RowMap>
__device__ __forceinline__ void transpose_item(const float* W, int K, int N, bf16* WT, int item, int lane, const RowMap& rm) {
    const int nblk = N / 32, kb = item / nblk, nb = item % nblk, k0 = 64 * kb, n0 = 32 * nb, fr = lane & 15, fq = lane >> 4;
    float v[2][2][8];
#pragma unroll
    for (int kh = 0; kh < 2; ++kh)
#pragma unroll
        for (int j = 0; j < 8; ++j)
#pragma unroll
            for (int nt = 0; nt < 2; ++nt) v[kh][nt][j] = W[(size_t)(k0 + 32 * kh + 8 * fq + j) * N + n0 + 16 * nt + fr];
#pragma unroll
    for (int nt = 0; nt < 2; ++nt) { bf16* orow = WT + (size_t)rm(n0 + 16 * nt + fr) * K + k0 + 8 * fq;
#pragma unroll
        for (int kh = 0; kh < 2; ++kh) *(GAS v4u*)(orow + 32 * kh) = (v4u){pk2(v[kh][nt][0], v[kh][nt][1]), pk2(v[kh][nt][2], v[kh][nt][3]), pk2(v[kh][nt][4], v[kh][nt][5]), pk2(v[kh][nt][6], v[kh][nt][7])}; }
}
template <class RowMap>
__device__ __forceinline__ void transpose_item_f8(const float* W, int K, int N, unsigned char* WT, int item, int lane, const RowMap& rm) {
    const int nblk = N / 32, kb = item / nblk, nb = item % nblk, k0 = 64 * kb, n0 = 32 * nb, fr = lane & 15, fq = lane >> 4;
    float v[2][2][8];
#pragma unroll
    for (int kh = 0; kh < 2; ++kh)
#pragma unroll
        for (int j = 0; j < 8; ++j)
#pragma unroll
            for (int nt = 0; nt < 2; ++nt) v[kh][nt][j] = 32.f * W[(size_t)(k0 + 32 * kh + 8 * fq + j) * N + n0 + 16 * nt + fr];
#pragma unroll
    for (int nt = 0; nt < 2; ++nt) { unsigned char* orow = WT + (size_t)rm(n0 + 16 * nt + fr) * K + k0 + 8 * fq;
#pragma unroll
        for (int kh = 0; kh < 2; ++kh) *(GAS v2u*)(orow + 32 * kh) = (v2u){pk4_fp8(v[kh][nt][0], v[kh][nt][1], v[kh][nt][2], v[kh][nt][3]), pk4_fp8(v[kh][nt][4], v[kh][nt][5], v[kh][nt][6], v[kh][nt][7])}; }
}
struct MapWin { __device__ __forceinline__ int operator()(int n) const { if (n < 2560) return n; if (n < 2576) return PDT + (n - 2560); if (n < 4624) return n - 16; if (n < 4640) return PGL + (n - 4624); return n - 32; } };
struct MapId { __device__ __forceinline__ int operator()(int n) const { return n; } };
struct MapGU { int half; __device__ __forceinline__ int operator()(int c) const { return 256 * (c >> 7) + 128 * half + (c & 127); } };

__device__ __forceinline__ void phase0(const Args& a, Frame& F) {
    const float* c = a.in[1]; const float* w_ada = a.in[2]; const float* b_ada = a.in[3];
    float* mod = (float*)(a.ws + WS_MOD);
    if (F.vcu < 192) {
        LAS float* cond = (LAS float*)(F.lds + 98304);
        LAS float* part = (LAS float*)(F.lds + 98304 + 16384);
        for (int i = F.tid; i < 4096; i += 512) cond[i] = silu_f(c[i]);
        __syncthreads();
        const int col0 = 32 * F.vcu, rsub = F.lane >> 3, c4 = F.lane & 7;
        f32x4 acc[4];
#pragma unroll
        for (int b = 0; b < 4; ++b) acc[b] = (f32x4){0.f, 0.f, 0.f, 0.f};
#pragma unroll 4
        for (int it = 0; it < 16; ++it) { const int k = 128 * F.wave + 8 * it + rsub; const f32x4 wv = *(const f32x4*)(w_ada + (size_t)k * 6144 + col0 + 4 * c4);
#pragma unroll
            for (int b = 0; b < 4; ++b) acc[b] += wv * cond[b * 1024 + k]; }
#pragma unroll
        for (int b = 0; b < 4; ++b)
#pragma unroll
            for (int j = 0; j < 4; ++j) { float v = acc[b][j]; v += __shfl_xor(v, 8); v += __shfl_xor(v, 16); v += __shfl_xor(v, 32); acc[b][j] = v; }
        if (rsub == 0) {
#pragma unroll
            for (int b = 0; b < 4; ++b)
#pragma unroll
                for (int j = 0; j < 4; ++j) part[(F.wave * 4 + b) * 32 + 4 * c4 + j] = acc[b][j]; }
        __syncthreads();
        if (F.tid < 128) { const int b = F.tid >> 5, cc = F.tid & 31; float s = b_ada[col0 + cc];
#pragma unroll
            for (int w = 0; w < 8; ++w) s += part[(w * 4 + b) * 32 + cc];
            mod[b * 6144 + col0 + cc] = s; }
        __syncthreads();
    }
    const int gw = F.vcu * 8 + F.wave, NGW = F.G * 8;
    bf16* WinT = (bf16*)(a.ws + WS_WIN); bf16* WoutT = (bf16*)(a.ws + WS_WOUT);
    constexpr int I_IN = 16 * 177, I_OUT = 32 * 32;
    for (int it = gw; it < I_IN + I_OUT; it += NGW) {
        if (it < I_IN) transpose_item(a.in[5], 1024, 5664, WinT, it, F.lane, MapWin());
        else transpose_item(a.in[15], 2048, 1024, WoutT, it - I_IN, F.lane, MapId());
    }
    for (int i = F.vcu * 512 + F.tid; i < 224 * 1024 / 8; i += F.G * 512) *(v4u*)(WinT + (size_t)5664 * 1024 + (size_t)i * 8) = (v4u){0u, 0u, 0u, 0u};
}
__device__ __forceinline__ void phase1(const Args& a, Frame& F) {
    const float* x = a.in[0]; const float* g1 = a.in[4]; const float* mod = (const float*)(a.ws + WS_MOD); bf16* H = (bf16*)(a.ws + WS_H);
    const int gw = F.vcu * 8 + F.wave, NGW = F.G * 8;
    f32x4 Gm[4], Sh[4], nx[4]; int bprev = -1;
    if (gw < T) {
#pragma unroll
        for (int j = 0; j < 4; ++j) nx[j] = ((const f32x4*)(x + (size_t)gw * D) + F.lane)[64 * j]; }
    for (int m = gw; m < T; m += NGW) {
        const int b = m / SEQ;
        f32x4 v[4]; float s = 0.f;
#pragma unroll
        for (int j = 0; j < 4; ++j) { v[j] = nx[j]; s += (v[j].x * v[j].x + v[j].y * v[j].y) + (v[j].z * v[j].z + v[j].w * v[j].w); }
        if (m + NGW < T) {
#pragma unroll
            for (int j = 0; j < 4; ++j) nx[j] = ((const f32x4*)(x + (size_t)(m + NGW) * D) + F.lane)[64 * j]; }
        if (b != bprev) { bprev = b;
#pragma unroll
            for (int j = 0; j < 4; ++j) { const int d0 = 4 * F.lane + 256 * j; Gm[j] = *(const f32x4*)(g1 + d0) * (*(const f32x4*)(mod + b * 6144 + 1024 + d0) + 1.f); Sh[j] = *(const f32x4*)(mod + b * 6144 + d0); } }
        const float rstd = 1.f / sqrtf(wave_sum(s) * (1.f / D) + EPS);
        v2u* o8 = (v2u*)(H + (size_t)m * D) + F.lane;
#pragma unroll
        for (int j = 0; j < 4; ++j) { const f32x4 h = v[j] * rstd * Gm[j] + Sh[j]; v2u w; w.x = pk2(h.x, h.y); w.y = pk2(h.z, h.w); o8[64 * j] = w; }
    }
}
__device__ __forceinline__ void phase3(const Args& a, Frame& F) {
    const bf16* P = (const bf16*)(a.ws + WS_PROJ); bf16* XA = (bf16*)a.out; float* GK = (float*)(a.ws + WS_GK); float* DT = (float*)(a.ws + WS_DT); bf16* KD = (bf16*)(a.ws + WS_KD); float* DKL = (float*)(a.ws + WS_DKL);
    const float* cw = a.in[6]; const float* cb = a.in[7]; const float* dtb = a.in[8]; const float* wg2 = a.in[12]; const float* bgl = a.in[13];
    const int gt = F.vcu * 512 + F.tid, NT = F.G * 512;
    for (int cidx = F.vcu; cidx < T / 64; cidx += F.G) {
        const int t0 = cidx * 64, k = F.tid; LAS v4u* gl = (LAS v4u*)F.lds;
        LAS float* lrun = (LAS float*)(F.lds + 4096);
        __syncthreads();
        if (F.tid < 128) gl[F.tid] = *(const v4u*)(P + (size_t)(t0 + (F.tid >> 1)) * NIN + PGL + 8 * (F.tid & 1));
        v4u kk8[8];
#pragma unroll
        for (int i = 0; i < 8; ++i) kk8[i] = *(const v4u*)(P + (size_t)(t0 + (F.tid >> 6) + 8 * i) * NIN + PK + 8 * (F.tid & 63));
        float wv[16];
#pragma unroll
        for (int r = 0; r < 16; ++r) wv[r] = wg2[r * 512 + k];
        const float bias = bgl[k]; float run = 0.f;
        __syncthreads();
#pragma unroll 4
        for (int l = 0; l < 64; ++l) {
            const v4u g0 = gl[2 * l], g1 = gl[2 * l + 1]; const unsigned gw[8] = {g0.x, g0.y, g0.z, g0.w, g1.x, g1.y, g1.z, g1.w};
            float s = bias;
#pragma unroll
            for (int r = 0; r < 8; ++r) { s += bflo(gw[r]) * wv[2 * r]; s += bfhi(gw[r]) * wv[2 * r + 1]; }
            run += logsigmoid_f(s) * (1.f / 16.f); GK[(size_t)(t0 + l) * 512 + k] = run; lrun[l * 512 + k] = run; }
        DKL[(size_t)cidx * 512 + k] = __expf(run);
        __syncthreads();
#pragma unroll
        for (int i = 0; i < 8; ++i) { const int l = (F.tid >> 6) + 8 * i, k0 = 8 * (F.tid & 63);
            const v4u kk = kk8[i];
            const f32x4 l0 = *(const LAS f32x4*)(lrun + 63 * 512 + k0), l1 = *(const LAS f32x4*)(lrun + 63 * 512 + k0 + 4), c0 = *(const LAS f32x4*)(lrun + l * 512 + k0), c1 = *(const LAS f32x4*)(lrun + l * 512 + k0 + 4);
            const float bl[8] = {l0.x, l0.y, l0.z, l0.w, l1.x, l1.y, l1.z, l1.w}, bc[8] = {c0.x, c0.y, c0.z, c0.w, c1.x, c1.y, c1.z, c1.w}; const unsigned kw[4] = {kk.x, kk.y, kk.z, kk.w}; unsigned ko[4];
#pragma unroll
            for (int j = 0; j < 4; ++j) ko[j] = pk2(bflo(kw[j]) * __expf(bl[2 * j] - bc[2 * j]), bfhi(kw[j]) * __expf(bl[2 * j + 1] - bc[2 * j + 1]));
            *(v4u*)(KD + (size_t)(t0 + l) * 512 + k0) = (v4u){ko[0], ko[1], ko[2], ko[3]}; }
    }
    { float* SW = (float*)(a.ws + WS_SW); float* SCD = (float*)(a.ws + WS_SCD); const float* a_log = a.in[9];
      for (int u = F.vcu * 8 + F.wave; u < NB * 32 * 16; u += F.G * 8) { const int h = u & 15, bc = u >> 4, t0 = bc * 128, i = F.lane;
        const float av = -__expf(a_log[h]);
        const float d0 = softplus_f(bf2f(P[(size_t)(t0 + 2 * i) * NIN + PDT + h]) + dtb[h]), d1 = softplus_f(bf2f(P[(size_t)(t0 + 2 * i + 1) * NIN + PDT + h]) + dtb[h]);
        DT[(size_t)(t0 + 2 * i) * 16 + h] = d0; DT[(size_t)(t0 + 2 * i + 1) * 16 + h] = d1;
        const float a0 = d0 * av, a1 = d1 * av; float s = a0 + a1;
#pragma unroll
        for (int o = 1; o < 64; o <<= 1) { const float t = __shfl_up(s, o); if (i >= o) s += t; }
        const float cend = __shfl(s, 63);
        SW[(size_t)(t0 + 2 * i) * 16 + h] = d0 * __expf(cend - (s - a1)); SW[(size_t)(t0 + 2 * i + 1) * 16 + h] = d1 * __expf(cend - s);
        if (i == 63) SCD[u] = __expf(cend); } }
    { const int cq = gt % 192, tb0 = gt / 192, c0 = cq * 8; const int TBS = NT / 192; constexpr int NTB = T / 8;
      if (tb0 < TBS) {
        f32x4 wl[4][2];
#pragma unroll
        for (int r = 0; r < 4; ++r) { wl[r][0] = *(const f32x4*)(cw + r * 1536 + c0); wl[r][1] = *(const f32x4*)(cw + r * 1536 + c0 + 4); }
        const f32x4 b0 = *(const f32x4*)(cb + c0), b1 = *(const f32x4*)(cb + c0 + 4);
        v4u rows[11], nrows[11];
        auto ld_rows = [&](int tb, v4u (&rw)[11]) { const int t0 = tb * 8; const bool first = (t0 % SEQ) == 0;
#pragma unroll
            for (int rr = 0; rr < 11; ++rr) { if (rr < 3 && first) rw[rr] = (v4u){0u, 0u, 0u, 0u}; else rw[rr] = *(const v4u*)(P + (size_t)(t0 - 3 + rr) * NIN + PX + c0); } };
        ld_rows(tb0, rows);
        for (int tb = tb0; tb < NTB; tb += TBS) { const int t0 = tb * 8;
            if (tb + TBS < NTB) ld_rows(tb + TBS, nrows);
#pragma unroll
            for (int tt = 0; tt < 8; ++tt) { f32x4 o0 = b0, o1 = b1;
#pragma unroll
                for (int r = 0; r < 4; ++r) { const v4u pv = rows[tt + r];
                    o0 += wl[r][0] * (f32x4){bflo(pv.x), bfhi(pv.x), bflo(pv.y), bfhi(pv.y)}; o1 += wl[r][1] * (f32x4){bflo(pv.z), bfhi(pv.z), bflo(pv.w), bfhi(pv.w)}; }
                *(v4u*)(XA + (size_t)(t0 + tt) * 1536 + c0) = (v4u){pk2(silu_f(o0.x), silu_f(o0.y)), pk2(silu_f(o0.z), silu_f(o0.w)), pk2(silu_f(o1.x), silu_f(o1.y)), pk2(silu_f(o1.z), silu_f(o1.w))}; }
#pragma unroll
            for (int rr = 0; rr < 11; ++rr) rows[rr] = nrows[rr];
        } } }
}
typedef LAS unsigned char* ldsp;
#define MFMA16(a, b, c) __builtin_amdgcn_mfma_f32_16x16x32_bf16(a, b, c, 0, 0, 0)
__device__ __forceinline__ bf16x8 ldfrag(ldsp base, int row, int stride, int kel) { return *(const LAS bf16x8*)(base + row * stride + kel * 2); }
constexpr float QSCALE = 0.08838834764831845f;

__device__ __forceinline__ void ssd_dtcs(const Args& a, Frame& F, int b, int c, int g, LAS float* dtv, LAS float* csv, float* cd_out) {
    const float* DT = (const float*)(a.ws + WS_DT); const int t0 = b * SEQ + c * 128, hh = F.wave, h = g * 8 + hh, i = F.lane;
    const float av = -__expf(a.in[9][h]);
    const float d0 = DT[(size_t)(t0 + 2 * i) * 16 + h], d1 = DT[(size_t)(t0 + 2 * i + 1) * 16 + h];
    const float a0 = d0 * av, a1 = d1 * av; float s = a0 + a1;
#pragma unroll
    for (int o = 1; o < 64; o <<= 1) { const float t = __shfl_up(s, o); if (i >= o) s += t; }
    dtv[hh * 128 + 2 * i] = d0; dtv[hh * 128 + 2 * i + 1] = d1; csv[hh * 128 + 2 * i] = s - a1; csv[hh * 128 + 2 * i + 1] = s;
    if (cd_out != nullptr && i == 63) cd_out[(b * 32 + c) * 16 + h] = __expf(s);
}
__device__ __forceinline__ void p4a_ssd(const Args& a, Frame& F, int item) {
    const int b = item >> 6, c = (item >> 1) & 31, g = item & 1, t0 = b * SEQ + c * 128;
    const bf16* XA = (const bf16*)a.out; bf16* SS = (bf16*)(a.ws + WS_SS);
    ldsp BT = F.lds, xwT = F.lds + 34816; LAS float* dtv = (LAS float*)(F.lds + 52224); LAS float* csv = dtv + 1024;
    const int w = F.wave, fr = F.lane & 15, fq = F.lane >> 4;
    ssd_dtcs(a, F, b, c, g, dtv, csv, (float*)(a.ws + WS_CD));
#pragma unroll
    for (int q = 0; q < 4; ++q) { const int idx = F.tid + 512 * q, n = idx & 127, lc = idx >> 7; const bf16* xb = XA + (size_t)t0 * 1536; const unsigned off = (unsigned)(8 * lc * 1536 + 1024 + g * 128 + n);
        unsigned e[8];
#pragma unroll
        for (int j = 0; j < 8; ++j) e[j] = (xb + j * 1536)[off];
        *(LAS v4u*)(BT + n * 272 + lc * 16) = (v4u){e[0] | (e[1] << 16), e[2] | (e[3] << 16), e[4] | (e[5] << 16), e[6] | (e[7] << 16)}; }
    __syncthreads();
    bf16x8 Bf[4];
#pragma unroll
    for (int ks = 0; ks < 4; ++ks) Bf[ks] = ldfrag(BT, 16 * w + fr, 272, 32 * ks + 8 * fq);
    for (int hh = 0; hh < 8; ++hh) {
        const int h = g * 8 + hh; const float cend = csv[hh * 128 + 127];
#pragma unroll
        for (int q = 0; q < 2; ++q) { const int idx = F.tid + 512 * q, p = idx & 63, lc = idx >> 6; const bf16* xb = XA + (size_t)t0 * 1536 + g * 512 + hh * 64; const unsigned off = (unsigned)(8 * lc * 1536 + p);
            float f[8];
#pragma unroll
            for (int j = 0; j < 8; ++j) { const int l = 8 * lc + j; f[j] = bf2f((xb + j * 1536)[off]) * dtv[hh * 128 + l] * __expf(cend - csv[hh * 128 + l]); }
            *(LAS v4u*)(xwT + p * 272 + lc * 16) = (v4u){pk2(f[0], f[1]), pk2(f[2], f[3]), pk2(f[4], f[5]), pk2(f[6], f[7])}; }
        __syncthreads();
        f32x4 acc[4];
#pragma unroll
        for (int tp = 0; tp < 4; ++tp) acc[tp] = (f32x4){0.f, 0.f, 0.f, 0.f};
#pragma unroll
        for (int ks = 0; ks < 4; ++ks)
#pragma unroll
            for (int tp = 0; tp < 4; ++tp) acc[tp] = MFMA16(Bf[ks], ldfrag(xwT, 16 * tp + fr, 272, 32 * ks + 8 * fq), acc[tp]);
#pragma unroll
        for (int tp = 0; tp < 4; ++tp) *(v2u*)(SS + ((size_t)((b * 32 + c) * 16 + h) * 64 + 16 * tp + fr) * 128 + 16 * w + 4 * fq) = (v2u){pk2(acc[tp][0], acc[tp][1]), pk2(acc[tp][2], acc[tp][3])};
        __syncthreads();
    }
}
__device__ __forceinline__ void p4a_gla(const Args& a, Frame& F, int item) {
    const int b = item >> 8, c = (item >> 2) & 63, h = item & 3, t0 = b * SEQ + c * 64;
    const bf16* P = (const bf16*)(a.ws + WS_PROJ); const float* BC = (const float*)(a.ws + WS_GK); bf16* GS = (bf16*)(a.ws + WS_GS); float* GD = (float*)(a.ws + WS_GD);
    ldsp kdT = F.lds, vT = F.lds + 18432;
    const int w = F.wave, fr = F.lane & 15, fq = F.lane >> 4;
#pragma unroll
    for (int q = 0; q < 2; ++q) { const int idx = F.tid + 512 * q, k = idx & 127, lc = idx >> 7;
        const float bl = BC[(size_t)(t0 + 63) * 512 + h * 128 + k]; float f[8];
#pragma unroll
        for (int j = 0; j < 8; ++j) { const int l = 8 * lc + j; f[j] = bf2f(P[(size_t)(t0 + l) * NIN + PK + h * 128 + k]) * __expf(bl - BC[(size_t)(t0 + l) * 512 + h * 128 + k]); }
        *(LAS v4u*)(kdT + k * 144 + lc * 16) = (v4u){pk2(f[0], f[1]), pk2(f[2], f[3]), pk2(f[4], f[5]), pk2(f[6], f[7])};
        if (lc == 0) GD[((b * 64 + c) * 4 + h) * 128 + k] = __expf(bl); }
#pragma unroll
    for (int q = 0; q < 4; ++q) { const int idx = F.tid + 512 * q, v = idx & 255, lc = idx >> 8; const bf16* pb = P + (size_t)t0 * NIN + PV + h * 256; const unsigned off = (unsigned)(8 * lc * NIN + v);
        unsigned e[8];
#pragma unroll
        for (int j = 0; j < 8; ++j) e[j] = (pb + j * NIN)[off];
        *(LAS v4u*)(vT + v * 144 + lc * 16) = (v4u){e[0] | (e[1] << 16), e[2] | (e[3] << 16), e[4] | (e[5] << 16), e[6] | (e[7] << 16)}; }
    __syncthreads();
    bf16x8 Kf[2];
#pragma unroll
    for (int ks = 0; ks < 2; ++ks) Kf[ks] = ldfrag(kdT, 16 * w + fr, 144, 32 * ks + 8 * fq);
#pragma unroll
    for (int tg = 0; tg < 4; ++tg) { f32x4 acc[4];
#pragma unroll
        for (int i = 0; i < 4; ++i) acc[i] = (f32x4){0.f, 0.f, 0.f, 0.f};
#pragma unroll
        for (int ks = 0; ks < 2; ++ks)
#pragma unroll
            for (int i = 0; i < 4; ++i) acc[i] = MFMA16(Kf[ks], ldfrag(vT, 16 * (4 * tg + i) + fr, 144, 32 * ks + 8 * fq), acc[i]);
#pragma unroll
        for (int i = 0; i < 4; ++i) *(v2u*)(GS + ((size_t)((b * 64 + c) * 4 + h) * 256 + 16 * (4 * tg + i) + fr) * 128 + 16 * w + 4 * fq) = (v2u){pk2(acc[i][0], acc[i][1]), pk2(acc[i][2], acc[i][3])}; }
    __syncthreads();
}
__device__ __forceinline__ void p4b_scan(const Args& a, Frame& F) {
    bf16* SS = (bf16*)(a.ws + WS_SS); bf16* GS = (bf16*)(a.ws + WS_GS); const float* CD = (const float*)(a.ws + WS_CD); const float* GD = (const float*)(a.ws + WS_GD);
    for (int gid = F.vcu * 512 + F.tid; gid < 131072; gid += F.G * 512) {
        { const int b = gid >> 15, rem = gid & 32767, h = rem >> 11, r2 = rem & 2047; float run[4] = {0.f, 0.f, 0.f, 0.f};
          for (int c0 = 0; c0 < 32; c0 += 16) { v2u ld[16]; float dec[16];
#pragma unroll
            for (int u = 0; u < 16; ++u) { ld[u] = *(const v2u*)(SS + (size_t)((b * 32 + c0 + u) * 16 + h) * 8192 + r2 * 4); dec[u] = CD[(b * 32 + c0 + u) * 16 + h]; }
#pragma unroll
            for (int u = 0; u < 16; ++u) { *(v2u*)(SS + (size_t)((b * 32 + c0 + u) * 16 + h) * 8192 + r2 * 4) = (v2u){pk2(run[0], run[1]), pk2(run[2], run[3])};
                run[0] = run[0] * dec[u] + bflo(ld[u].x); run[1] = run[1] * dec[u] + bfhi(ld[u].x); run[2] = run[2] * dec[u] + bflo(ld[u].y); run[3] = run[3] * dec[u] + bfhi(ld[u].y); } } }
        { const int b = gid >> 15, rem = gid & 32767, h = rem >> 13, r2 = rem & 8191, k4 = r2 & 31; float run[4] = {0.f, 0.f, 0.f, 0.f};
          for (int c0 = 0; c0 < 64; c0 += 16) { v2u ld[16]; f32x4 dec[16];
#pragma unroll
            for (int u = 0; u < 16; ++u) { ld[u] = *(const v2u*)(GS + (size_t)((b * 64 + c0 + u) * 4 + h) * 32768 + r2 * 4); dec[u] = *(const f32x4*)(GD + ((b * 64 + c0 + u) * 4 + h) * 128 + 4 * k4); }
#pragma unroll
            for (int u = 0; u < 16; ++u) { *(v2u*)(GS + (size_t)((b * 64 + c0 + u) * 4 + h) * 32768 + r2 * 4) = (v2u){pk2(run[0], run[1]), pk2(run[2], run[3])};
                run[0] = run[0] * dec[u].x + bflo(ld[u].x); run[1] = run[1] * dec[u].y + bfhi(ld[u].x); run[2] = run[2] * dec[u].z + bflo(ld[u].y); run[3] = run[3] * dec[u].w + bfhi(ld[u].y); } } }
    }
}
#define LDS_SYNC() asm volatile("s_waitcnt lgkmcnt(0)\n\ts_barrier" ::: "memory")
__device__ __forceinline__ int swz128(int row) { return (((row >> 1) & 1) | (((row >> 3) & 1) << 1)) << 1; }
typedef short v4s_ __attribute__((ext_vector_type(4)));
__device__ __forceinline__ bf16x8 ldfrag_tr128(ldsp tile, int kbase, int c0, int lane) {
    const int g = lane >> 4, q = (lane >> 2) & 3, p = lane & 3, col = (c0 + 4 * p) * 2;
    ldsp ad = tile + (kbase + 8 * g + q) * 128 + ((((col >> 4) ^ (((q >> 1) | ((g & 1) << 1)) << 1)) << 4) | (col & 15));
    const v4s_ lo = __builtin_amdgcn_ds_read_tr16_b64_v4i16((LAS v4s_*)ad), hi = __builtin_amdgcn_ds_read_tr16_b64_v4i16((LAS v4s_*)(ad + 4 * 128));
    return __builtin_shufflevector(lo, hi, 0, 1, 2, 3, 4, 5, 6, 7);
}
__device__ __forceinline__ int swz256(int row) { return ((row & 3) | (((row >> 3) & 1) << 2)) << 1; }
__device__ __forceinline__ bf16x8 ldfrag_tr512(ldsp tile, int kbase, int c0, int lane) {
    const int g = lane >> 4, q = (lane >> 2) & 3, p = lane & 3, col = (c0 + 4 * p) * 2;
    ldsp ad = tile + (kbase + 8 * g + q) * 512 + ((((col >> 4) ^ ((q | ((g & 1) << 2)) << 1)) << 4) | (col & 15));
    const v4s_ lo = __builtin_amdgcn_ds_read_tr16_b64_v4i16((LAS v4s_*)ad), hi = __builtin_amdgcn_ds_read_tr16_b64_v4i16((LAS v4s_*)(ad + 4 * 512));
    return __builtin_shufflevector(lo, hi, 0, 1, 2, 3, 4, 5, 6, 7);
}
__device__ __forceinline__ void p4c_ssd(const Args& a, Frame& F, int item) {
    const int b = item >> 6, c = (item >> 1) & 31, g = item & 1, t0 = b * SEQ + c * 128;
    const bf16* P = (const bf16*)(a.ws + WS_PROJ); const bf16* XA = (const bf16*)a.out; const bf16* SS = (const bf16*)(a.ws + WS_SS); bf16* MX = (bf16*)(a.ws + WS_MIX);
    const float* dsk = a.in[10]; const float* sng = a.in[11];
    ldsp Cs = F.lds, Ms0 = F.lds + 34816; LAS float* dtv = (LAS float*)(F.lds + 104448); LAS float* csv = dtv + 1024;
    const int w = (F.wave < 4) ? F.wave : 11 - F.wave, fr = F.lane & 15, fq = F.lane >> 4, l = 16 * w + fr;
    v4u xr[2], pr[2]; v2u zr[4];
    auto ld_head = [&](int hn) {
#pragma unroll
        for (int q = 0; q < 2; ++q) { const int idx = F.tid + 512 * q; xr[q] = *(const v4u*)(XA + (size_t)(t0 + (idx >> 3)) * 1536 + g * 512 + hn * 64 + 8 * (idx & 7)); }
#pragma unroll
        for (int q = 0; q < 2; ++q) { const int idx = F.tid + 512 * q; pr[q] = *(const v4u*)(SS + ((size_t)((b * 32 + c) * 16 + g * 8 + hn) * 64 + (idx >> 4)) * 128 + 8 * (idx & 15)); }
#pragma unroll
        for (int tp = 0; tp < 4; ++tp) zr[tp] = *(const v2u*)(P + (size_t)(t0 + l) * NIN + PZ + g * 512 + hn * 64 + 16 * tp + 4 * fq);
    };
    ld_head(0);
    ssd_dtcs(a, F, b, c, g, dtv, csv, nullptr);
    LAS float* dskl = (LAS float*)(F.lds + 147456);
    LAS float* gaml = (LAS float*)(F.lds + 147520);
    if (F.tid < 8) dskl[F.tid] = dsk[g * 8 + F.tid];
    if (F.tid < 128) *(LAS f32x4*)(gaml + 4 * F.tid) = *(const f32x4*)(sng + g * 512 + 4 * F.tid);
#pragma unroll
    for (int q = 0; q < 4; ++q) { const int idx = F.tid + 512 * q, ll = idx >> 4, ch = idx & 15;
        *(LAS v4u*)(Cs + ll * 272 + ch * 16) = *(const v4u*)(XA + (size_t)(t0 + ll) * 1536 + 1280 + g * 128 + 8 * ch);
        *(LAS v4u*)(Ms0 + ll * 272 + ch * 16) = *(const v4u*)(XA + (size_t)(t0 + ll) * 1536 + 1024 + g * 128 + 8 * ch); }
    __syncthreads();
    bf16x8 Cf[4];
#pragma unroll
    for (int ks = 0; ks < 4; ++ks) Cf[ks] = ldfrag(Cs, l, 272, 32 * ks + 8 * fq);
    f32x4 cb[8];
#pragma unroll
    for (int ts = 0; ts < 8; ++ts) { cb[ts] = (f32x4){0.f, 0.f, 0.f, 0.f};
        if (ts <= w) {
#pragma unroll
            for (int ks = 0; ks < 4; ++ks) cb[ts] = MFMA16(ldfrag(Ms0, 16 * ts + fr, 272, 32 * ks + 8 * fq), Cf[ks], cb[ts]); } }
    __syncthreads();
    float ssq = 0.f;
#pragma unroll 1
    for (int hh = 0; hh < 8; ++hh) {
        const bool odd = (hh & 1) != 0; ldsp Ms = odd ? F.lds : F.lds + 34816; ldsp xs = odd ? F.lds + 112640 : F.lds + 69632; ldsp prevs = odd ? F.lds + 130048 : F.lds + 87040;
#pragma unroll
        for (int q = 0; q < 2; ++q) { const int idx = F.tid + 512 * q, row = idx >> 3, ch = idx & 7; *(LAS v4u*)(xs + row * 128 + ((ch ^ swz128(row)) << 4)) = xr[q]; }
#pragma unroll
        for (int q = 0; q < 2; ++q) { const int idx = F.tid + 512 * q, p = idx >> 4, ch = idx & 15; *(LAS v4u*)(prevs + p * 272 + ch * 16) = pr[q]; }
        v2u zc[4];
#pragma unroll
        for (int tp = 0; tp < 4; ++tp) zc[tp] = zr[tp];
        const float csl = csv[hh * 128 + l];
#pragma unroll
        for (int ts = 0; ts < 8; ++ts) { float m[4] = {0.f, 0.f, 0.f, 0.f};
            if (ts <= w) { const f32x4 c4 = *(const LAS f32x4*)(csv + hh * 128 + 16 * ts + 4 * fq), d4 = *(const LAS f32x4*)(dtv + hh * 128 + 16 * ts + 4 * fq);
#pragma unroll
                for (int j = 0; j < 4; ++j) { const int s = 16 * ts + 4 * fq + j; const float v = cb[ts][j] * __expf(fminf(csl - c4[j], 0.f)) * d4[j]; m[j] = (s <= l) ? v : 0.f; } }
            *(LAS v2u*)(Ms + l * 272 + (16 * ts + 4 * fq) * 2) = (v2u){pk2(m[0], m[1]), pk2(m[2], m[3])}; }
        LDS_SYNC();
        if (hh + 1 < 8) ld_head(hh + 1);
        f32x4 y1[4], y2[4];
#pragma unroll
        for (int tp = 0; tp < 4; ++tp) { y1[tp] = (f32x4){0.f, 0.f, 0.f, 0.f}; y2[tp] = (f32x4){0.f, 0.f, 0.f, 0.f}; }
        const int ksmax = (16 * w + 15) >> 5;
        for (int ks = 0; ks <= ksmax; ++ks) { const bf16x8 Mf = ldfrag(Ms, l, 272, 32 * ks + 8 * fq);
#pragma unroll
            for (int tp = 0; tp < 4; ++tp) y1[tp] = MFMA16(ldfrag_tr128(xs, 32 * ks, 16 * tp, F.lane), Mf, y1[tp]); }
#pragma unroll
        for (int ks = 0; ks < 4; ++ks)
#pragma unroll
            for (int tp = 0; tp < 4; ++tp) y2[tp] = MFMA16(ldfrag(prevs, 16 * tp + fr, 272, 32 * ks + 8 * fq), Cf[ks], y2[tp]);
        const float el = __expf(csl), dk = dskl[hh];
#pragma unroll
        for (int tp = 0; tp < 4; ++tp) { const int p0 = 16 * tp + 4 * fq; const v2u zz = zc[tp];
            const float zf[4] = {bflo(zz.x), bfhi(zz.x), bflo(zz.y), bfhi(zz.y)}; float u[4];
            const v2u x4 = *(const LAS v2u*)(xs + l * 128 + ((((p0 * 2) >> 4) ^ swz128(l)) << 4) + ((p0 * 2) & 15)); const float xf[4] = {bflo(x4.x), bfhi(x4.x), bflo(x4.y), bfhi(x4.y)};
#pragma unroll
            for (int j = 0; j < 4; ++j) { const float y = y1[tp][j] + y2[tp][j] * el + dk * xf[j]; u[j] = y * silu_f(zf[j]); ssq += u[j] * u[j]; }
            *(v2u*)(MX + (size_t)(t0 + l) * 2048 + g * 512 + hh * 64 + p0) = (v2u){pk2(u[0], u[1]), pk2(u[2], u[3])}; }
    }
    __syncthreads();
    ssq += __shfl_xor(ssq, 16); ssq += __shfl_xor(ssq, 32);
    const float rstd = 1.f / sqrtf(ssq * (1.f / 512.f) + EPS);
    LAS float* rsl = (LAS float*)(F.lds + 149568);
    if (fq == 0) rsl[l] = rstd;
    VM_WAIT();
    __syncthreads();
#pragma unroll 1
    for (int hb = 0; hb < 2; ++hb) {
        v4u wv[8];
#pragma unroll
        for (int i = 0; i < 8; ++i) { const int id = (8 * hb + i) * 512 + F.tid; wv[i] = *(const v4u*)(MX + (size_t)(t0 + (id >> 6)) * 2048 + g * 512 + 8 * (id & 63)); }
        asm volatile("" ::: "memory");
#pragma unroll
        for (int i = 0; i < 8; ++i) { const int id = (8 * hb + i) * 512 + F.tid, row = id >> 6, c8 = 8 * (id & 63); const float r = rsl[row];
            const f32x4 g0 = *(const LAS f32x4*)(gaml + c8), g1 = *(const LAS f32x4*)(gaml + c8 + 4);
            *(v4u*)(MX + (size_t)(t0 + row) * 2048 + g * 512 + c8) = (v4u){pk2(bflo(wv[i].x) * r * g0.x, bfhi(wv[i].x) * r * g0.y), pk2(bflo(wv[i].y) * r * g0.z, bfhi(wv[i].y) * r * g0.w),
                                                                          pk2(bflo(wv[i].z) * r * g1.x, bfhi(wv[i].z) * r * g1.y), pk2(bflo(wv[i].w) * r * g1.z, bfhi(wv[i].w) * r * g1.w)}; }
    }
    __syncthreads();
}
struct GlaStage { v4u q8[2], k8[2]; f32x4 b0[2], b1[2]; };
__device__ __forceinline__ void gla_stage_load(GlaStage& S, const Args& a, Frame& F, int item) {
    const int b = item >> 8, c = (item >> 2) & 63, h = item & 3, t0 = b * SEQ + c * 64;
    const bf16* P = (const bf16*)(a.ws + WS_PROJ); const float* BC = (const float*)(a.ws + WS_GK);
#pragma unroll
    for (int q = 0; q < 2; ++q) { const int idx = F.tid + 512 * q, l = idx >> 4, ch = idx & 15;
        S.q8[q] = *(const v4u*)(P + (size_t)(t0 + l) * NIN + PQ + h * 128 + 8 * ch); S.k8[q] = *(const v4u*)(P + (size_t)(t0 + l) * NIN + PK + h * 128 + 8 * ch);
        const f32x4* bp = (const f32x4*)(BC + (size_t)(t0 + l) * 512 + h * 128 + 8 * ch); S.b0[q] = bp[0]; S.b1[q] = bp[1]; }
}
__device__ __forceinline__ void p4c_gla(const Args& a, Frame& F, int item, GlaStage& S, int next_item) {
    const int b = item >> 8, c = (item >> 2) & 63, h = item & 3, t0 = b * SEQ + c * 64;
    const bf16* P = (const bf16*)(a.ws + WS_PROJ); const float* BC = (const float*)(a.ws + WS_GK); const bf16* GS = (const bf16*)(a.ws + WS_GS); bf16* MX = (bf16*)(a.ws + WS_MIX); const float* gng = a.in[14];
    ldsp qt = F.lds, kt = F.lds + 17408, att = F.lds + 34816, vT = F.lds + 44032; LAS float* part = (LAS float*)(F.lds + 80896);
    const int w = F.wave, fr = F.lane & 15, fq = F.lane >> 4;
    bf16x8 PF[2][4]; v2u rrv[4][2]; v4u vv[4];
#pragma unroll
    for (int q = 0; q < 4; ++q) { const int idx = F.tid + 512 * q, row = idx >> 5, ch = idx & 31; vv[q] = *(const v4u*)(P + (size_t)(t0 + row) * NIN + PV + h * 256 + 8 * ch); }
#pragma unroll
    for (int tl = 0; tl < 4; ++tl)
#pragma unroll
        for (int tvi = 0; tvi < 2; ++tvi) rrv[tl][tvi] = *(const v2u*)(P + (size_t)(t0 + 16 * tl + fr) * NIN + PR + h * 256 + 16 * (2 * w + tvi) + 4 * fq);
#pragma unroll
    for (int q = 0; q < 2; ++q) { const int idx = F.tid + 512 * q, l = idx >> 4, ch = idx & 15;
        const v4u q8 = S.q8[q], k8 = S.k8[q]; const f32x4 b0 = S.b0[q], b1 = S.b1[q];
        const float bc[8] = {b0.x, b0.y, b0.z, b0.w, b1.x, b1.y, b1.z, b1.w}; const unsigned qw[4] = {q8.x, q8.y, q8.z, q8.w}, kw[4] = {k8.x, k8.y, k8.z, k8.w}; unsigned qo[4], ko[4];
#pragma unroll
        for (int j = 0; j < 4; ++j) { const float e0 = __expf(bc[2 * j]), e1 = __expf(bc[2 * j + 1]), i0 = __expf(-bc[2 * j]), i1 = __expf(-bc[2 * j + 1]);
            qo[j] = pk2(bflo(qw[j]) * e0 * QSCALE, bfhi(qw[j]) * e1 * QSCALE); ko[j] = pk2(bflo(kw[j]) * i0, bfhi(kw[j]) * i1); }
        *(LAS v4u*)(qt + l * 272 + ch * 16) = (v4u){qo[0], qo[1], qo[2], qo[3]}; *(LAS v4u*)(kt + l * 272 + ch * 16) = (v4u){ko[0], ko[1], ko[2], ko[3]}; }
    asm volatile("" ::: "memory");
    LDS_SYNC();
    if (next_item >= 0) gla_stage_load(S, a, F, next_item);
#pragma unroll
    for (int tvi = 0; tvi < 2; ++tvi)
#pragma unroll
        for (int ks = 0; ks < 4; ++ks) PF[tvi][ks] = *(const bf16x8*)(GS + ((size_t)((b * 64 + c) * 4 + h) * 256 + 16 * (2 * w + tvi) + fr) * 128 + 32 * ks + 8 * fq);
#pragma unroll
    for (int ti = 0; ti < 2; ++ti) { const int id = 2 * w + ti, tl = id >> 2, ts = id & 3; f32x4 acc = (f32x4){0.f, 0.f, 0.f, 0.f};
        if (ts <= tl) {
#pragma unroll
            for (int ks = 0; ks < 4; ++ks) acc = MFMA16(ldfrag(kt, 16 * ts + fr, 272, 32 * ks + 8 * fq), ldfrag(qt, 16 * tl + fr, 272, 32 * ks + 8 * fq), acc); }
        const int l = 16 * tl + fr; float m[4];
#pragma unroll
        for (int j = 0; j < 4; ++j) { const int s = 16 * ts + 4 * fq + j; m[j] = (s <= l) ? acc[j] : 0.f; }
        *(LAS v2u*)(att + l * 144 + (16 * ts + 4 * fq) * 2) = (v2u){pk2(m[0], m[1]), pk2(m[2], m[3])}; }
#pragma unroll
    for (int q = 0; q < 4; ++q) { const int idx = F.tid + 512 * q, row = idx >> 5, ch = idx & 31; *(LAS v4u*)(vT + row * 512 + ((ch ^ swz256(row)) << 4)) = vv[q]; }
    LDS_SYNC();
    f32x4 o[4][2];
#pragma unroll
    for (int tl = 0; tl < 4; ++tl) {
        bf16x8 af[2], qf[4];
#pragma unroll
        for (int ks = 0; ks < 2; ++ks) af[ks] = ldfrag(att, 16 * tl + fr, 144, 32 * ks + 8 * fq);
#pragma unroll
        for (int ks = 0; ks < 4; ++ks) qf[ks] = ldfrag(qt, 16 * tl + fr, 272, 32 * ks + 8 * fq);
        f32x4 a0 = (f32x4){0.f, 0.f, 0.f, 0.f}, a1 = (f32x4){0.f, 0.f, 0.f, 0.f};
#pragma unroll
        for (int ks = 0; ks < 2; ++ks) { a0 = MFMA16(ldfrag_tr512(vT, 32 * ks, 16 * (2 * w), F.lane), af[ks], a0); a1 = MFMA16(ldfrag_tr512(vT, 32 * ks, 16 * (2 * w + 1), F.lane), af[ks], a1); }
#pragma unroll
        for (int ks = 0; ks < 4; ++ks) { a0 = MFMA16(PF[0][ks], qf[ks], a0); a1 = MFMA16(PF[1][ks], qf[ks], a1); }
        o[tl][0] = a0; o[tl][1] = a1;
    }
#pragma unroll
    for (int tl = 0; tl < 4; ++tl) { float s = 0.f;
#pragma unroll
        for (int tvi = 0; tvi < 2; ++tvi)
#pragma unroll
            for (int j = 0; j < 4; ++j) s += o[tl][tvi][j] * o[tl][tvi][j];
        s += __shfl_xor(s, 16); s += __shfl_xor(s, 32);
        if (fq == 0) part[w * 64 + 16 * tl + fr] = s; }
    LDS_SYNC();
#pragma unroll
    for (int tl = 0; tl < 4; ++tl) { const int l = 16 * tl + fr; float tot = 0.f;
#pragma unroll
        for (int w8 = 0; w8 < 8; ++w8) tot += part[w8 * 64 + l];
        const float rstd = 1.f / sqrtf(tot * (1.f / 256.f) + EPS);
#pragma unroll
        for (int tvi = 0; tvi < 2; ++tvi) { const int v0 = 16 * (2 * w + tvi) + 4 * fq; const v2u rr = rrv[tl][tvi]; const f32x4 gg = *(const f32x4*)(gng + v0);
            const f32x4 ov = o[tl][tvi];
            *(v2u*)(MX + (size_t)(t0 + l) * 2048 + 1024 + h * 256 + v0) = (v2u){pk2(ov[0] * rstd * gg.x * silu_f(bflo(rr.x)), ov[1] * rstd * gg.y * silu_f(bfhi(rr.x))), pk2(ov[2] * rstd * gg.z * silu_f(bflo(rr.y)), ov[3] * rstd * gg.w * silu_f(bfhi(rr.y)))}; } }
    LDS_SYNC();
}
__device__ __forceinline__ void lds_put16(ldsp base, int off, unsigned v) { *(LAS unsigned short*)(base + off) = (unsigned short)v; }
typedef short v4s __attribute__((ext_vector_type(4)));
__device__ __forceinline__ bf16x8 ldfrag_tr(ldsp tile, int stride, int kbase, int c0, int lane) {
    const int g = lane >> 4, q = (lane >> 2) & 3, p = lane & 3;
    ldsp ad = tile + (kbase + 8 * g + q) * stride + (c0 + 4 * p) * 2;
    const v4s lo = __builtin_amdgcn_ds_read_tr16_b64_v4i16((LAS v4s*)ad), hi = __builtin_amdgcn_ds_read_tr16_b64_v4i16((LAS v4s*)(ad + 4 * stride));
    return __builtin_shufflevector(lo, hi, 0, 1, 2, 3, 4, 5, 6, 7);
}
__device__ __forceinline__ void glds16(const char* g, ldsp l) { __builtin_amdgcn_global_load_lds((const unsigned*)g, (LAS unsigned*)l, 16, 0, 0); }
__device__ __forceinline__ void glds4(const char* g, ldsp l) { __builtin_amdgcn_global_load_lds((const unsigned*)g, (LAS unsigned*)l, 4, 0, 0); }
template <int N> __device__ __forceinline__ void wait_vm() { asm volatile("s_waitcnt vmcnt(%0)" :: "n"(N) : "memory"); }
struct TrFrag { v2u lo, hi; };
template <int OFF> __device__ __forceinline__ v2u ds_tr_b64(unsigned addr) { v2u r; asm volatile("ds_read_b64_tr_b16 %0, %1 offset:%2" : "=v"(r) : "v"(addr), "n"(OFF) : "memory"); return r; }
template <int KB, int TOFF> __device__ __forceinline__ TrFrag tr256(unsigned sbase, int c0, int lane) {
    const int g = lane >> 4, q = (lane >> 2) & 3, p = lane & 3, col = (c0 + 4 * p) * 2;
    const unsigned ad = sbase + (unsigned)((8 * g + q) * 256 + ((((col >> 4) ^ ((q | ((g & 1) << 2)) << 1)) << 4) | (col & 15)));
    TrFrag f; f.lo = ds_tr_b64<TOFF + KB * 256>(ad); f.hi = ds_tr_b64<TOFF + KB * 256 + 1024>(ad); return f;
}
template <int KB, int TOFF> __device__ __forceinline__ TrFrag tr128(unsigned sbase, int c0, int lane) {
    const int g = lane >> 4, q = (lane >> 2) & 3, p = lane & 3, col = (c0 + 4 * p) * 2;
    const unsigned ad = sbase + (unsigned)((8 * g + q) * 128 + ((((col >> 4) ^ (((q >> 1) | ((g & 1) << 1)) << 1)) << 4) | (col & 15)));
    TrFrag f; f.lo = ds_tr_b64<TOFF + KB * 128>(ad); f.hi = ds_tr_b64<TOFF + KB * 128 + 512>(ad); return f;
}
__device__ __forceinline__ bf16x8 frag8(const TrFrag& f) { return __builtin_bit_cast(bf16x8, (v4u){f.lo.x, f.lo.y, f.hi.x, f.hi.y}); }
#define TR_TIE5(f0, f1, f2, f3, f4) asm volatile("s_waitcnt lgkmcnt(0)" : "+v"(f0.lo), "+v"(f0.hi), "+v"(f1.lo), "+v"(f1.hi), "+v"(f2.lo), "+v"(f2.hi), "+v"(f3.lo), "+v"(f3.hi), "+v"(f4.lo), "+v"(f4.hi) :: "memory")
constexpr int CH_DP = 5, CH_SLOT = 25600, CH_NL = 7, CH_STG = CH_DP * CH_SLOT, CH_STG_BYTES = 64 * 272, CH_DUMP = CH_STG + 2 * CH_STG_BYTES + 128, CH_WARM = 6;
__device__ __forceinline__ void ch_stage_state(ldsp stg, const f32x4 (&S)[2][4], int w, int fr, int fq) {
#pragma unroll
    for (int rb = 0; rb < 2; ++rb)
#pragma unroll
        for (int t = 0; t < 4; ++t) *(LAS v2u*)(stg + (16 * t + fr) * 272 + (32 * w + 16 * rb + 4 * fq) * 2) = (v2u){pk2(S[rb][t][0], S[rb][t][1]), pk2(S[rb][t][2], S[rb][t][3])};
}
__device__ __forceinline__ void ch_store_state(ldsp stg, char* dst, int t) {
    v4u r[4];
#pragma unroll
    for (int i = 0; i < 4; ++i) { const int id = i * 256 + t; r[i] = *(const LAS v4u*)(stg + (id >> 4) * 272 + (id & 15) * 16); }
#pragma unroll
    for (int i = 0; i < 4; ++i) *(v4u*)(dst + (size_t)(i * 256 + t) * 16) = r[i];
}
__device__ __forceinline__ void st_ssd_chain(const Args& a, Frame& F, int id) {
    const int b = id >> 4, h = id & 15, g = h >> 3, w = F.wave, lane = F.lane, fr = lane & 15, fq = lane >> 4;
    const char* XA = (const char*)a.out; const char* SW = (const char*)(a.ws + WS_SW); const float* SCD = (const float*)(a.ws + WS_SCD); char* SS = (char*)(a.ws + WS_SS);
    LAS float* dect = (LAS float*)(F.lds + CH_STG + 2 * CH_STG_BYTES);
    if (F.tid < 32) dect[F.tid] = SCD[(b * 32 + F.tid) * 16 + h];
    if (w >= 4) {
        const int t = F.tid - 256;
        const unsigned owarm = (t < 128) ? (unsigned)((t >> 1) * 3072 + (1024 + g * 128) * 2 + (t & 1) * 128) : (t < 192) ? (unsigned)((t - 128) * 3072 + h * 128) : 0xffffffffu;
        for (int hs = 0; hs <= 62; ++hs) {
            LDS_SYNC();
            if ((hs & 1) == 0) { const int c = hs >> 1; ch_store_state(F.lds + CH_STG + (c & 1) * CH_STG_BYTES, SS + ((size_t)((b * 32 + c) * 16 + h)) * 16384, t); }
            { const int hw = hs + CH_WARM <= 61 ? hs + CH_WARM : 61; const int t0 = b * SEQ + hw * 64;
              const char* wp = (owarm != 0xffffffffu) ? XA + (size_t)t0 * 3072 + owarm : SW + (size_t)t0 * 64 + (unsigned)(((t - 192) & 31) * 128 + h * 4);
              glds4(wp, F.lds + CH_DUMP); }
        }
        LDS_SYNC();
        return;
    }
    unsigned ob[4], ox[2], owv;
#pragma unroll
    for (int i = 0; i < 4; ++i) { const int A = (i * 4 + w) * 1024 + lane * 16, row = A >> 8, lc = ((A >> 4) & 15) ^ swz256(row); ob[i] = (unsigned)(row * 3072 + (1024 + g * 128) * 2 + lc * 16); }
#pragma unroll
    for (int i = 0; i < 2; ++i) { const int A = (i * 4 + w) * 1024 + lane * 16, row = A >> 7, lc = ((A >> 4) & 7) ^ swz128(row); ox[i] = (unsigned)(row * 3072 + h * 128 + lc * 16); }
    owv = (unsigned)((lane * 16 + h) * 4);
    auto issue = [&](int hs, int slot) {
        const int t0 = b * SEQ + hs * 64; const char* xb = XA + (size_t)t0 * 3072; const char* wb = SW + (size_t)t0 * 64; ldsp s = F.lds + slot * CH_SLOT;
#pragma unroll
        for (int i = 0; i < 4; ++i) glds16(xb + ob[i], s + (i * 4 + w) * 1024);
#pragma unroll
        for (int i = 0; i < 2; ++i) glds16(xb + ox[i], s + 16384 + (i * 4 + w) * 1024);
        glds4(wb + owv, s + 24576);
    };
    f32x4 S[2][4];
#pragma unroll
    for (int rb = 0; rb < 2; ++rb)
#pragma unroll
        for (int tp = 0; tp < 4; ++tp) S[rb][tp] = (f32x4){0.f, 0.f, 0.f, 0.f};
    asm volatile("s_waitcnt vmcnt(0)" ::: "memory");
#pragma unroll
    for (int j = 0; j < CH_DP - 1; ++j) issue(j, j);
    int slot = 0, nslot = CH_DP - 1;
    for (int hs = 0; hs <= 62; ++hs) {
        const int c = hs >> 1;
        if ((hs & 1) == 0) ch_stage_state(F.lds + CH_STG + (c & 1) * CH_STG_BYTES, S, w, fr, fq);
        wait_vm<(CH_DP - 2) * CH_NL>();
        LDS_SYNC();
        if (hs == 62) break;
        { const int hn = hs + CH_DP - 1; issue(hn <= 61 ? hn : 61, nslot); }
        ldsp s = F.lds + slot * CH_SLOT; const unsigned sb = (unsigned)(size_t)s;
        TrFrag Bq[2][2], xq[2][4];
#pragma unroll
        for (int rb = 0; rb < 2; ++rb) { Bq[0][rb] = tr256<0, 0>(sb, 32 * w + 16 * rb, lane); Bq[1][rb] = tr256<32, 0>(sb, 32 * w + 16 * rb, lane); }
#pragma unroll
        for (int tp = 0; tp < 4; ++tp) { xq[0][tp] = tr128<0, 16384>(sb, 16 * tp, lane); xq[1][tp] = tr128<32, 16384>(sb, 16 * tp, lane); }
        if ((hs & 1) == 0) { const float dec = dect[c];
#pragma unroll
            for (int rb = 0; rb < 2; ++rb)
#pragma unroll
                for (int tp = 0; tp < 4; ++tp) S[rb][tp] = S[rb][tp] * dec; }
        TR_TIE5(Bq[0][0], Bq[0][1], Bq[1][0], Bq[1][1], xq[0][0]); TR_TIE5(xq[0][1], xq[0][2], xq[0][3], xq[1][0], xq[1][1]);
        asm volatile("s_waitcnt lgkmcnt(0)" : "+v"(xq[1][2].lo), "+v"(xq[1][2].hi), "+v"(xq[1][3].lo), "+v"(xq[1][3].hi) :: "memory");
#pragma unroll
        for (int ks = 0; ks < 2; ++ks) {
            const f32x4 w0 = *(const LAS f32x4*)(s + 24576 + (32 * ks + 8 * fq) * 4), w1 = *(const LAS f32x4*)(s + 24576 + (32 * ks + 8 * fq + 4) * 4);
#pragma unroll
            for (int rb = 0; rb < 2; ++rb) {
                const v4u bw = {Bq[ks][rb].lo.x, Bq[ks][rb].lo.y, Bq[ks][rb].hi.x, Bq[ks][rb].hi.y};
                const v4u bs = {pk2(bflo(bw.x) * w0.x, bfhi(bw.x) * w0.y), pk2(bflo(bw.y) * w0.z, bfhi(bw.y) * w0.w), pk2(bflo(bw.z) * w1.x, bfhi(bw.z) * w1.y), pk2(bflo(bw.w) * w1.z, bfhi(bw.w) * w1.w)};
                const bf16x8 Bf = __builtin_bit_cast(bf16x8, bs);
#pragma unroll
                for (int tp = 0; tp < 4; ++tp) S[rb][tp] = MFMA16(Bf, frag8(xq[ks][tp]), S[rb][tp]); } }
        slot = (slot + 1 == CH_DP) ? 0 : slot + 1; nslot = (nslot + 1 == CH_DP) ? 0 : nslot + 1;
    }
    wait_vm<0>();
    LDS_SYNC();
}
__device__ __forceinline__ void st_gla_chain(const Args& a, Frame& F, int id) {
    const int b = id >> 4, h = (id >> 2) & 3, vq = id & 3, w = F.wave, lane = F.lane, fr = lane & 15, fq = lane >> 4;
    const char* KD = (const char*)(a.ws + WS_KD); const char* P = (const char*)(a.ws + WS_PROJ); const char* DKL = (const char*)(a.ws + WS_DKL); char* GS = (char*)(a.ws + WS_GS);
    if (w >= 4) {
        const int t = F.tid - 256;
        for (int c = 0; c <= 63; ++c) {
            LDS_SYNC();
            ch_store_state(F.lds + CH_STG + (c & 1) * CH_STG_BYTES, GS + (((size_t)((b * 64 + c) * 4 + h)) * 256 + vq * 64) * 256, t);
            { const int cw = c + CH_WARM <= 62 ? c + CH_WARM : 62; const int t0 = b * SEQ + cw * 64;
              const char* wp = (t < 128) ? KD + (size_t)(t0 + (t >> 1)) * 1024 + h * 256 + (t & 1) * 128
                             : (t < 192) ? P + (size_t)(t0 + (t - 128)) * (NIN * 2) + (PV + h * 256 + vq * 64) * 2
                                         : DKL + ((size_t)(b * 64 + cw) * 512 + h * 128) * 4 + ((t - 192) & 3) * 128;
              glds4(wp, F.lds + CH_DUMP); }
        }
        LDS_SYNC();
        return;
    }
    unsigned okd[4], ov[2];
#pragma unroll
    for (int i = 0; i < 4; ++i) { const int A = (i * 4 + w) * 1024 + lane * 16, row = A >> 8, lc = ((A >> 4) & 15) ^ swz256(row); okd[i] = (unsigned)(row * 1024 + h * 256 + lc * 16); }
#pragma unroll
    for (int i = 0; i < 2; ++i) { const int A = (i * 4 + w) * 1024 + lane * 16, row = A >> 7, lc = ((A >> 4) & 7) ^ swz128(row); ov[i] = (unsigned)(row * (NIN * 2) + (PV + h * 256 + vq * 64) * 2 + lc * 16); }
    auto issue = [&](int c, int slot) {
        const int t0 = b * SEQ + c * 64; const char* kb = KD + (size_t)t0 * 1024; const char* pb = P + (size_t)t0 * (NIN * 2); const char* db = DKL + ((size_t)(b * 64 + c) * 512 + h * 128) * 4; ldsp s = F.lds + slot * CH_SLOT;
#pragma unroll
        for (int i = 0; i < 4; ++i) glds16(kb + okd[i], s + (i * 4 + w) * 1024);
#pragma unroll
        for (int i = 0; i < 2; ++i) glds16(pb + ov[i], s + 16384 + (i * 4 + w) * 1024);
        glds16(db + lane * 16, s + 24576);
    };
    f32x4 S[2][4];
#pragma unroll
    for (int rb = 0; rb < 2; ++rb)
#pragma unroll
        for (int tv = 0; tv < 4; ++tv) S[rb][tv] = (f32x4){0.f, 0.f, 0.f, 0.f};
    asm volatile("s_waitcnt vmcnt(0)" ::: "memory");
#pragma unroll
    for (int j = 0; j < CH_DP - 1; ++j) issue(j, j);
    int slot = 0, nslot = CH_DP - 1;
    for (int c = 0; c <= 63; ++c) {
        ch_stage_state(F.lds + CH_STG + (c & 1) * CH_STG_BYTES, S, w, fr, fq);
        wait_vm<(CH_DP - 2) * CH_NL>();
        LDS_SYNC();
        if (c == 63) break;
        { const int cn = c + CH_DP - 1; issue(cn <= 62 ? cn : 62, nslot); }
        ldsp s = F.lds + slot * CH_SLOT; const unsigned sb = (unsigned)(size_t)s;
        TrFrag Kq[2][2], vq2[2][4];
#pragma unroll
        for (int rb = 0; rb < 2; ++rb) { Kq[0][rb] = tr256<0, 0>(sb, 32 * w + 16 * rb, lane); Kq[1][rb] = tr256<32, 0>(sb, 32 * w + 16 * rb, lane); }
#pragma unroll
        for (int tv = 0; tv < 4; ++tv) { vq2[0][tv] = tr128<0, 16384>(sb, 16 * tv, lane); vq2[1][tv] = tr128<32, 16384>(sb, 16 * tv, lane); }
#pragma unroll
        for (int rb = 0; rb < 2; ++rb) { const f32x4 dk4 = *(const LAS f32x4*)(s + 24576 + (32 * w + 16 * rb + 4 * fq) * 4);
#pragma unroll
            for (int tv = 0; tv < 4; ++tv) S[rb][tv] = S[rb][tv] * dk4; }
        TR_TIE5(Kq[0][0], Kq[0][1], Kq[1][0], Kq[1][1], vq2[0][0]); TR_TIE5(vq2[0][1], vq2[0][2], vq2[0][3], vq2[1][0], vq2[1][1]);
        asm volatile("s_waitcnt lgkmcnt(0)" : "+v"(vq2[1][2].lo), "+v"(vq2[1][2].hi), "+v"(vq2[1][3].lo), "+v"(vq2[1][3].hi) :: "memory");
#pragma unroll
        for (int ks = 0; ks < 2; ++ks)
#pragma unroll
            for (int rb = 0; rb < 2; ++rb)
#pragma unroll
                for (int tv = 0; tv < 4; ++tv) S[rb][tv] = MFMA16(frag8(Kq[ks][rb]), frag8(vq2[ks][tv]), S[rb][tv]);
        slot = (slot + 1 == CH_DP) ? 0 : slot + 1; nslot = (nslot + 1 == CH_DP) ? 0 : nslot + 1;
    }
    wait_vm<0>();
    LDS_SYNC();
}
__device__ __forceinline__ void phase6b_range(const Args& a, Frame& F, int cw, int ncw);
__device__ __forceinline__ void phase6b_tickets(const Args& a, Frame& F);
constexpr int CV_DP = 4, CV_SLOT = 32768, CV_T = CV_DP * CV_SLOT, CV_TB = 64 * 144, CV_STEPS = 96 * 128;
#ifndef CV_OWNER_STEPS
#define CV_OWNER_STEPS 12
#endif
constexpr int CV_EARLY_WGS = 64, CV_EARLY_STEPS = 20, CV_EARLY = CV_EARLY_WGS * CV_EARLY_STEPS;
__device__ __forceinline__ void cv_mat(int m, int& e, int& kind) { if (m < 48) { e = m >> 1; kind = m & 1; } else if (m < 80) { e = m - 48; kind = 2; } else { e = 24 + ((m - 80) >> 1); kind = (m - 80) & 1; } }
__device__ __forceinline__ void cvt_stream(const Args& a, Frame& F, int sid0, int stride, int nst);
__device__ __forceinline__ void phase_states(const Args& a, Frame& F) {
    for (int r = F.vcu; r < 256; r += F.G) {
        const int xcd = r >> 5, idx = r & 31;
        if (idx < 8) st_ssd_chain(a, F, xcd * 8 + idx);
        else if (idx < 16) st_gla_chain(a, F, xcd * 8 + idx - 8);
        { constexpr int REST = CV_STEPS - CV_EARLY, NOWN = 128 * CV_OWNER_STEPS, NOTH = (REST - NOWN) / 128; static_assert((REST - NOWN) % 128 == 0, "tile split");
          const int j = xcd * 16 + (idx & 15);
          if (idx < 16) cvt_stream(a, F, CV_EARLY + 128 * NOTH + j, 128, CV_OWNER_STEPS); else cvt_stream(a, F, CV_EARLY + j, 128, NOTH); }
    }
}
__device__ __forceinline__ void phase4a(const Args& a, Frame& F) { for (int it = F.vcu; it < 1280; it += F.G) { if (it < 256) p4a_ssd(a, F, it); else p4a_gla(a, F, it - 256); } }
__device__ __forceinline__ void phase4c(const Args& a, Frame& F) {
    int it = F.vcu;
    for (; it < 256; it += F.G) p4c_ssd(a, F, it);
    if (it < 1280) {
        GlaStage S; gla_stage_load(S, a, F, it - 256);
        for (; it < 1280; it += F.G) p4c_gla(a, F, it - 256, S, (it + F.G < 1280) ? it + F.G - 256 : -1); }
}
__device__ __forceinline__ void phase6(const Args& a, Frame& F) {
    const float* X1 = a.out; const float* g2 = a.in[16]; const float* wr = a.in[17]; const float* br = a.in[18]; const float* mod = (const float*)(a.ws + WS_MOD);
    bf16* H2 = (bf16*)(a.ws + WS_H2); unsigned* cntw = (unsigned*)(a.ws + WS_CTL) + CW_CNT; unsigned* list = (unsigned*)(a.ws + WS_LIST);
    const int gw = F.vcu * 8 + F.wave, NGW = F.G * 8;
    LAS float* wl = (LAS float*)F.lds;
    LAS unsigned* lcnt = (LAS unsigned*)(F.lds + 147456);
    LAS unsigned* lbase = lcnt + 32; LAS unsigned* lent = lcnt + 64; LAS unsigned* ltok = lent + 1024;
    if (F.tid < 32) lcnt[F.tid] = 0u;
    const int nmax = (T + NGW - 1) / NGW;
    for (int s = F.tid; s < nmax * 32; s += 512) lent[s] = 0xffffffffu;
    int nloc = 0;
#pragma unroll 4
    for (int i = F.tid; i < 8192; i += 512) { const int d = i >> 3, q = i & 7, pd = (d & ~255) + 64 * (d & 3) + ((d >> 2) & 63); *(LAS f32x4*)(wl + pd * WR_STRIDE + 4 * q) = *(const f32x4*)(wr + d * 32 + 4 * q); }
    __syncthreads();
    float Gm[16], Sh[16]; int bprev = -1;
    f32x4 nx[4];
    if (gw < T) {
#pragma unroll
        for (int j = 0; j < 4; ++j) nx[j] = *(const f32x4*)(X1 + (size_t)gw * D + 256 * j + 4 * F.lane); }
    for (int m = gw; m < T; m += NGW) {
        const int b = m / SEQ; float hv[16]; float ss = 0.f;
#pragma unroll
        for (int j = 0; j < 4; ++j) { hv[4 * j] = nx[j].x; hv[4 * j + 1] = nx[j].y; hv[4 * j + 2] = nx[j].z; hv[4 * j + 3] = nx[j].w; }
        if (m + NGW < T) {
#pragma unroll
            for (int j = 0; j < 4; ++j) nx[j] = *(const f32x4*)(X1 + (size_t)(m + NGW) * D + 256 * j + 4 * F.lane); }
        if (b != bprev) { bprev = b;
#pragma unroll
            for (int jj = 0; jj < 16; ++jj) { const int d = 256 * (jj >> 2) + 4 * F.lane + (jj & 3); Gm[jj] = g2[d] * (1.f + mod[b * 6144 + 4096 + d]); Sh[jj] = mod[b * 6144 + 3072 + d]; } }
#pragma unroll
        for (int jj = 0; jj < 16; ++jj) ss += hv[jj] * hv[jj];
        const float rstd = 1.f / sqrtf(wave_sum(ss) * (1.f / D) + EPS);
#pragma unroll
        for (int jj = 0; jj < 16; ++jj) hv[jj] = hv[jj] * rstd * Gm[jj] + Sh[jj];
#pragma unroll
        for (int j = 0; j < 4; ++j) {
            if (MOE_FP8) *(unsigned*)((unsigned char*)H2 + (size_t)m * D + 256 * j + 4 * F.lane) = pk4_fp8(hv[4 * j], hv[4 * j + 1], hv[4 * j + 2], hv[4 * j + 3]);
            else *(v2u*)(H2 + (size_t)m * D + 256 * j + 4 * F.lane) = (v2u){pk2(hv[4 * j], hv[4 * j + 1]), pk2(hv[4 * j + 2], hv[4 * j + 3])}; }
        float acc[32];
#pragma unroll
        for (int e = 0; e < 32; ++e) acc[e] = 0.f;
#pragma unroll
        for (int jj = 0; jj < 16; ++jj) { const int pd = 256 * (jj >> 2) + 64 * (jj & 3) + F.lane; const LAS f32x4* wp = (const LAS f32x4*)(wl + pd * WR_STRIDE); const float h = hv[jj];
#pragma unroll
            for (int q = 0; q < 8; ++q) { const f32x4 w = wp[q]; acc[4 * q] += h * w.x; acc[4 * q + 1] += h * w.y; acc[4 * q + 2] += h * w.z; acc[4 * q + 3] += h * w.w; }
            if (jj & 1) asm volatile("" ::: "memory"); }
#pragma unroll
        for (int e = 0; e < 32; ++e) acc[e] += __shfl_xor(acc[e], 32);
        { const bool hi = (F.lane & 16) != 0;
#pragma unroll
          for (int i = 0; i < 16; ++i) { const float send = hi ? acc[i] : acc[i + 16], keep = hi ? acc[i + 16] : acc[i]; acc[i] = keep + __shfl_xor(send, 16); } }
        { const bool hi = (F.lane & 8) != 0;
#pragma unroll
          for (int i = 0; i < 8; ++i) { const float send = hi ? acc[i] : acc[i + 8], keep = hi ? acc[i + 8] : acc[i]; acc[i] = keep + __shfl_xor(send, 8); } }
        { const bool hi = (F.lane & 4) != 0;
#pragma unroll
          for (int i = 0; i < 4; ++i) { const float send = hi ? acc[i] : acc[i + 4], keep = hi ? acc[i + 4] : acc[i]; acc[i] = keep + __shfl_xor(send, 4); } }
        { const bool hi = (F.lane & 2) != 0;
#pragma unroll
          for (int i = 0; i < 2; ++i) { const float send = hi ? acc[i] : acc[i + 2], keep = hi ? acc[i + 2] : acc[i]; acc[i] = keep + __shfl_xor(send, 2); } }
        { const bool hi = (F.lane & 1) != 0; const float send = hi ? acc[0] : acc[1], keep = hi ? acc[1] : acc[0]; acc[0] = keep + __shfl_xor(send, 1); }
        const int e_me = F.lane & 31;
        float lv = acc[0] + br[e_me];
        float tv[4]; int ti[4];
#pragma unroll
        for (int k = 0; k < 4; ++k) {
            float mx = lv;
#pragma unroll
            for (int o = 1; o < 32; o <<= 1) mx = fmaxf(mx, __shfl_xor(mx, o));
            const unsigned long long bal = __ballot(lv == mx) & 0xffffffffull;
            const int idx = __builtin_ctzll(bal);
            tv[k] = mx; ti[k] = idx;
            if (e_me == idx) lv = -3.0e38f;
        }
        const float e1 = __expf(tv[1] - tv[0]), e2 = __expf(tv[2] - tv[0]), e3 = __expf(tv[3] - tv[0]); const float inv = 1.f / (1.f + e1 + e2 + e3);
        if (F.lane < 4) {
            const int k = F.lane; const int e = (k == 0) ? ti[0] : (k == 1) ? ti[1] : (k == 2) ? ti[2] : ti[3];
            const float w = ((k == 0) ? 1.f : (k == 1) ? e1 : (k == 2) ? e2 : e3) * inv;
            const unsigned lr = __hip_atomic_fetch_add(&lcnt[e], 1u, __ATOMIC_RELAXED, __HIP_MEMORY_SCOPE_WORKGROUP);
            const int slot = (nloc * 8 + F.wave) * 4 + k;
            lent[slot] = ((unsigned)e << 24) | lr; ltok[slot] = (unsigned)(m * 4 + k) | ((unsigned)__builtin_bit_cast(unsigned short, (_Float16)w) << 16);
        }
        ++nloc;
    }
    __syncthreads();
    if (F.tid < 32) lbase[F.tid] = atomicAdd(&cntw[F.tid * CNT_STRIDE], lcnt[F.tid]);
    __syncthreads();
    for (int s = F.tid; s < nmax * 32; s += 512) { const unsigned en = lent[s]; if (en != 0xffffffffu) { const unsigned e = en >> 24, lr = en & 0xffffffu; list[e * LCAP + lbase[e] + lr] = ltok[s]; } }
}
__device__ __forceinline__ void phase6b_range(const Args& a, Frame& F, int cw, int ncw) {
    for (int it = cw; it < 96 * 512; it += ncw) {
        const int mat = it >> 9, sub = it & 511, e = mat / 3, kind = mat % 3;
        if (kind == 0) transpose_item_f8(a.in[19] + (size_t)e * 1048576, 1024, 1024, a.ws + w1_off(e), sub, F.lane, MapGU{0});
        else if (kind == 1) transpose_item_f8(a.in[21] + (size_t)e * 1048576, 1024, 1024, a.ws + w1_off(e), sub, F.lane, MapGU{1});
        else transpose_item_f8(a.in[23] + (size_t)e * 1048576, 1024, 1024, a.ws + w2_off(e), sub, F.lane, MapId());
    }
}
__device__ __forceinline__ void phase6b(const Args& a, Frame& F) { phase6b_range(a, F, F.vcu * 8 + F.wave, F.G * 8); }
__device__ __forceinline__ void phase6b_tickets(const Args& a, Frame& F) {
    unsigned* ctr = (unsigned*)(a.ws + WS_CTL) + CW_CVT;
    for (;;) {
        unsigned base = 0u; if (F.lane == 0) base = atomicAdd(ctr, 16u);
        base = (unsigned)__builtin_amdgcn_readfirstlane((int)base);
        if (base >= 96u * 512u) break;
        for (int it = (int)base; it < (int)base + 16; ++it) {
            const int mat = it >> 9, sub = it & 511, e = mat / 3, kind = mat % 3;
            if (kind == 0) transpose_item_f8(a.in[19] + (size_t)e * 1048576, 1024, 1024, a.ws + w1_off(e), sub, F.lane, MapGU{0});
            else if (kind == 1) transpose_item_f8(a.in[21] + (size_t)e * 1048576, 1024, 1024, a.ws + w1_off(e), sub, F.lane, MapGU{1});
            else transpose_item_f8(a.in[23] + (size_t)e * 1048576, 1024, 1024, a.ws + w2_off(e), sub, F.lane, MapId());
        }
    }
}
__device__ __forceinline__ void cvt_stream(const Args& a, Frame& F, int sid0, int stride, int nst) {
    const int w = F.wave, lane = F.lane;
    if (w < 4) {
        unsigned og[8];
#pragma unroll
        for (int i = 0; i < 8; ++i) { const int A = (i * 4 + w) * 1024 + lane * 16, row = A >> 8, lc = ((A >> 4) & 15) ^ (((row >> 3) & 1) << 3); og[i] = (unsigned)(row * 4096 + lc * 16); }
        auto issue = [&](int i, int slot) {
            const int sid = sid0 + stride * (i < nst ? i : nst - 1), r = sid & 127, kb2 = r >> 4, nb = r & 15; int e, kind; cv_mat(sid >> 7, e, kind);
            const float* W = (kind == 0 ? a.in[19] : kind == 1 ? a.in[21] : a.in[23]) + (size_t)e * 1048576;
            const char* src = (const char*)(W + (size_t)kb2 * 128 * 1024 + nb * 64); ldsp sl = F.lds + slot * CV_SLOT;
#pragma unroll
            for (int k = 0; k < 8; ++k) __builtin_amdgcn_global_load_lds((const unsigned*)(src + og[k]), (LAS unsigned*)(sl + (k * 4 + w) * 1024), 16, 0, 2);
        };
        const int a2 = w >> 1, b2 = w & 1, q = lane >> 3, l = lane & 7;
        asm volatile("s_waitcnt vmcnt(0)" ::: "memory");
#pragma unroll
        for (int i = 0; i < CV_DP - 1; ++i) issue(i, i);
        for (int s = 0; s <= nst; ++s) {
            if (s < nst) wait_vm<(CV_DP - 2) * 8>();
            LDS_SYNC();
            if (s == nst) break;
            issue(s + CV_DP - 1, (s + CV_DP - 1) & (CV_DP - 1));
            ldsp sl = F.lds + (s & (CV_DP - 1)) * CV_SLOT; ldsp T = F.lds + CV_T + (s & 1) * CV_TB;
            f32x4 v[8];
#pragma unroll
            for (int jj = 0; jj < 8; ++jj) v[jj] = *(const LAS f32x4*)(sl + (a2 * 64 + 8 * q + jj) * 256 + (((b2 * 8 + l) ^ ((q & 1) << 3)) << 4));
#pragma unroll
            for (int i = 0; i < 4; ++i)
                *(LAS v2u*)(T + (b2 * 32 + 4 * l + i) * 144 + a2 * 64 + 8 * q) = (v2u){pk4_fp8(32.f * v[0][i], 32.f * v[1][i], 32.f * v[2][i], 32.f * v[3][i]), pk4_fp8(32.f * v[4][i], 32.f * v[5][i], 32.f * v[6][i], 32.f * v[7][i])};
        }
        wait_vm<0>();
    } else {
        const int t = F.tid - 256;
        for (int s = 0; s <= nst; ++s) {
            LDS_SYNC();
            if (s > 0) {
                const int sid = sid0 + stride * (s - 1), r = sid & 127, kb2 = r >> 4, nb = r & 15, n0 = nb * 64; int e, kind; cv_mat(sid >> 7, e, kind);
                unsigned char* dst = a.ws + (kind < 2 ? w1_off(e) : w2_off(e)) + (size_t)(kind < 2 ? 256 * (n0 >> 7) + 128 * kind + (n0 & 127) : n0) * 1024 + kb2 * 128;
                ldsp T = F.lds + CV_T + ((s - 1) & 1) * CV_TB;
                v4u d[2];
#pragma unroll
                for (int rr = 0; rr < 2; ++rr) { const int id = t + 256 * rr; d[rr] = *(const LAS v4u*)(T + (id >> 3) * 144 + (id & 7) * 16); }
#pragma unroll
                for (int rr = 0; rr < 2; ++rr) { const int id = t + 256 * rr; *(GAS v4u*)(dst + (size_t)(id >> 3) * 1024 + (id & 7) * 16) = d[rr]; }
            }
        }
    }
    LDS_SYNC();
}
__device__ __forceinline__ int moe_table(const Args& a, Frame& F) {
    LAS int* cnt = (LAS int*)(F.lds + TAB_OFF); LAS int* tstart = cnt + 32;
    const unsigned* cntw = (const unsigned*)(a.ws + WS_CTL) + CW_CNT;
    if (F.tid < 32) cnt[F.tid] = (int)__hip_atomic_load(cntw + F.tid * CNT_STRIDE, RLX_AGENT);
    __syncthreads();
    if (F.tid == 0) { int s = 0; for (int e = 0; e < 32; ++e) { tstart[e] = s; s += (cnt[e] + 255) >> 8; } tstart[32] = s; }
    __syncthreads();
    return tstart[32];
}
__device__ __forceinline__ void phase9(const Args& a, Frame& F, float* XO) {
    float* X = a.out; const bf16* SL = (const bf16*)(a.ws + WS_SLAB); const float* mod = (const float*)(a.ws + WS_MOD); const float* fg = a.in[25];
    const int gw = F.vcu * 8 + F.wave, NGW = F.G * 8;
    f32x4 Gt[4], Fg[4], nx[4]; v2u ns[4][4]; unsigned n8[4][4]; int bprev = -1;
#pragma unroll
    for (int j = 0; j < 4; ++j) Fg[j] = *(const f32x4*)(fg + 4 * F.lane + 256 * j);
    auto ld_row = [&](int m) {
#pragma unroll
        for (int j = 0; j < 4; ++j) { const int d0 = 4 * F.lane + 256 * j; nx[j] = *(const f32x4*)(X + (size_t)m * D + d0);
#pragma unroll
            for (int k = 0; k < 4; ++k) { if (SLAB_FP8) n8[j][k] = *(const unsigned*)((const unsigned char*)SL + ((size_t)m * 4 + k) * 1024 + d0); else ns[j][k] = *(const v2u*)(SL + ((size_t)m * 4 + k) * 1024 + d0); } }
    };
    if (gw < T) ld_row(gw);
    for (int m = gw; m < T; m += NGW) {
        const int b = m / SEQ; f32x4 v[4]; float s = 0.f;
        if (b != bprev) { bprev = b;
#pragma unroll
            for (int j = 0; j < 4; ++j) Gt[j] = *(const f32x4*)(mod + b * 6144 + 5120 + 4 * F.lane + 256 * j); }
#pragma unroll
        for (int j = 0; j < 4; ++j) { f32x4 f = (f32x4){0.f, 0.f, 0.f, 0.f};
#pragma unroll
            for (int k = 0; k < 4; ++k) {
                if (SLAB_FP8) { const int w8 = (int)n8[j][k]; f.x += __builtin_amdgcn_cvt_f32_fp8(w8, 0); f.y += __builtin_amdgcn_cvt_f32_fp8(w8, 1); f.z += __builtin_amdgcn_cvt_f32_fp8(w8, 2); f.w += __builtin_amdgcn_cvt_f32_fp8(w8, 3); }
                else { const v2u w = ns[j][k]; f.x += bflo(w.x); f.y += bfhi(w.x); f.z += bflo(w.y); f.w += bfhi(w.y); } }
            if (SLAB_FP8) f = f * (1.f / 32.f);
            v[j] = nx[j] + Gt[j] * f; s += (v[j].x * v[j].x + v[j].y * v[j].y) + (v[j].z * v[j].z + v[j].w * v[j].w); }
        if (m + NGW < T) ld_row(m + NGW);
        const float rstd = 1.f / sqrtf(wave_sum(s) * (1.f / D) + EPS);
#pragma unroll
        for (int j = 0; j < 4; ++j) { const int d0 = 4 * F.lane + 256 * j; *(f32x4*)(XO + (size_t)m * D + d0) = v[j] * rstd * Fg[j]; }
    }
}

#define PRB_KREP_IN 1
#define PRB_EPIREP_IN 1
#define PRB_KREP_GU 1
#define PRB_EPIREP_GU 1
#define PRB_KREP_DN 1
#define PRB_EPIREP_DN 1
#define PHASE_LIST X(0) X(1) X(2) X(3) X(17) X(6) X(7) X(8) X(9) X(10) X(11)
#define X(p) +1
constexpr int NPHASE = 0 PHASE_LIST;
#undef X
template <int PH> __device__ __forceinline__ void run_phase(const Args& args, Frame& F) {
    if constexpr (PH == 0) phase0(args, F);
    else if constexpr (PH == 1) phase1(args, F);
    else if constexpr (PH == 2) {
        DenseSched S{T / 256, NIN / 256, F.G, F.vcu, 2048, (const char*)(args.ws + WS_WIN)};
        EpiProj E{(bf16*)(args.ws + WS_PROJ)};
        pg8::gemm_phase<EpiProj, DenseSched, false, true, true, PRB_KREP_IN, PRB_EPIREP_IN>(F.lds, (const char*)(args.ws + WS_H), 2048, S, E);
        { const int nun = (T / 256) * (NIN / 256), full = nun / F.G, rem = nun - full * F.G;
          if (rem > 0 && F.vcu >= rem && F.vcu - rem < CV_EARLY_WGS && F.G - rem >= CV_EARLY_WGS) cvt_stream(args, F, F.vcu - rem, CV_EARLY_WGS, CV_EARLY_STEPS);
          else if (!(rem > 0 && F.G - rem >= CV_EARLY_WGS) && F.vcu < CV_EARLY_WGS) cvt_stream(args, F, F.vcu, CV_EARLY_WGS, CV_EARLY_STEPS); }
    }
    else if constexpr (PH == 3) phase3(args, F);
    else if constexpr (PH == 4) phase4a(args, F);
    else if constexpr (PH == 5) p4b_scan(args, F);
    else if constexpr (PH == 6) phase4c(args, F);
    else if constexpr (PH == 7) {
        DenseSched S{T / 256, D / 256, F.G, F.vcu, 4096, (const char*)(args.ws + WS_WOUT)};
        EpiRes E{args.in[0], args.out, (const float*)(args.ws + WS_MOD)};
        pg8::gemm_phase(F.lds, (const char*)(args.ws + WS_MIX), 4096, S, E);
    }
    else if constexpr (PH == 8) phase6(args, F);
    else if constexpr (PH == 9) {
        const int ntiles = moe_table(args, F);
        const LAS int* cnt = (const LAS int*)(F.lds + TAB_OFF);
        LAS int* toks = (LAS int*)(F.lds + RING_BYTES + 4096);
        moe_tokens(toks, 8, F.G, F.vcu, ntiles, cnt, cnt + 32, (const unsigned*)(args.ws + WS_LIST), F.tid);
        constexpr int EB = MOE_FP8 ? 1 : 2;
        MoeSched<true> S{8, F.G, F.vcu, 1024 * EB, ntiles, cnt, cnt + 32, toks, (const char*)args.ws, 1};
        LAS float* ept = (LAS float*)(F.lds + EPT_OFF);
        moe_epi_gateup(ept, 8, F.G, F.vcu, ntiles, cnt + 32, args.in[20], args.in[22], F.tid);
        EpiGateUp E{(bf16*)(args.ws + WS_ACT), ept};
        pg8::gemm_phase<EpiGateUp, MoeSched<true>, MOE_FP8 != 0, true, true, PRB_KREP_GU, PRB_EPIREP_GU>(F.lds, (const char*)(args.ws + WS_H2), 1024 * EB, S, E);
    }
    else if constexpr (PH == 10) {
        const int ntiles = moe_table(args, F);
        const LAS int* cnt = (const LAS int*)(F.lds + TAB_OFF);
        constexpr int EB = MOE_FP8 ? 1 : 2;
        MoeSched<false> S{4, F.G, F.vcu, 1024 * EB, ntiles, cnt, cnt + 32, nullptr, (const char*)args.ws, 2};
        LAS unsigned* ept = (LAS unsigned*)(F.lds + EPT_OFF);
        moe_epi_down(ept, 4, F.G, F.vcu, ntiles, cnt, cnt + 32, (const unsigned*)(args.ws + WS_LIST), args.in[24], F.tid);
        EpiDown E{(bf16*)(args.ws + WS_SLAB), ept};
        pg8::gemm_phase<EpiDown, MoeSched<false>, MOE_FP8 != 0, true, true, PRB_KREP_DN, PRB_EPIREP_DN>(F.lds, (const char*)(args.ws + WS_ACT), 1024 * EB, S, E);
    }
    else if constexpr (PH == 12) phase6b(args, F);
    else if constexpr (PH == 17) phase_states(args, F);
    else if constexpr (PH == 13) phase9(args, F, (float*)(args.ws + 1 * MiB));
    else if constexpr (PH == 14) { if (F.vcu == 0 && F.tid < 32) ((unsigned*)(args.ws + WS_CTL))[CW_CNT + F.tid * CNT_STRIDE] = 0u; }
    else phase9(args, F, args.out);
}
__global__ void __launch_bounds__(512, 2) mk_fwd(Args args) {
    extern __shared__ __attribute__((aligned(16))) unsigned char lds_raw[];
    Frame F; F.lds = (LAS unsigned char*)lds_raw; F.tid = threadIdx.x; F.lane = F.tid & 63; F.wave = __builtin_amdgcn_readfirstlane(F.tid >> 6);
    F.G = gridDim.x; { const int bx = blockIdx.x; F.vcu = (F.G % 8 == 0) ? (bx % 8) * (F.G / 8) + bx / 8 : bx; }
    volatile LAS unsigned* MISC = (volatile LAS unsigned*)(F.lds + MISC_OFF);
    if (F.tid < 32) MISC[F.tid] = 0u;
    __syncthreads();
    unsigned* ctl = (unsigned*)(args.ws + WS_CTL);
    XcdBarrier bar; bar.bar = ctl + CW_BAR; bar.x = 0; bar.st = nullptr;
    if (MK_N_LAUNCHES == 1) bar = xcd_barrier_post(ctl + CW_BAR, MISC + 8);
    const int lo = args.ph_lo, hi = args.ph_hi; int idx = 0;
#define X(p) { if (lo <= idx && idx < hi) run_phase<p>(args, F); if (lo <= idx && idx + 1 < hi) xcd_barrier(bar); ++idx; }
    PHASE_LIST
#undef X
}

extern "C" void kernel_launch(void* const* d_in, const int* in_sizes, int n_in, void* d_out, int out_size, void* d_ws, size_t ws_size, hipStream_t stream) {
    static int grid = 0;
    if (grid == 0) {
        if (n_in != 26 || out_size != T * D || ws_size < WS_END) { fprintf(stderr, "kernel_launch: unexpected shapes (n_in %d out %d ws %zu)\n", n_in, out_size, ws_size); grid = -1; return; }
        int dev = 0, cus = 0, per_cu = 0;
        if (hipGetDevice(&dev) != hipSuccess || hipDeviceGetAttribute(&cus, hipDeviceAttributeMultiprocessorCount, dev) != hipSuccess) { grid = -1; return; }
        if (hipFuncSetAttribute((const void*)mk_fwd, hipFuncAttributeMaxDynamicSharedMemorySize, LDS_BYTES) != hipSuccess) { fprintf(stderr, "kernel_launch: hipFuncSetAttribute failed\n"); grid = -1; return; }
        if (hipOccupancyMaxActiveBlocksPerMultiprocessor(&per_cu, (const void*)mk_fwd, 512, LDS_BYTES) != hipSuccess || per_cu < 1) { fprintf(stderr, "kernel_launch: occupancy query says %d\n", per_cu); per_cu = 1; }
        (void)hipGetLastError();
        grid = cus;
    }
    if (grid < 0) return;
    (void)hipMemsetAsync((char*)d_ws + WS_CTL, 0, CTL_ZERO_BYTES, stream);
    Args a{};
    for (int i = 0; i < 26; ++i) a.in[i] = (const float*)d_in[i];
    a.out = (float*)d_out; a.ws = (unsigned char*)d_ws;
    if (MK_N_LAUNCHES == 1) { a.ph_lo = 0; a.ph_hi = NPHASE; hipLaunchKernelGGL(mk_fwd, dim3(grid), dim3(512), LDS_BYTES, stream, a); }
    else { for (int p = 0; p < NPHASE; ++p) { a.ph_lo = p; a.ph_hi = p + 1; hipLaunchKernelGGL(mk_fwd, dim3(grid), dim3(512), LDS_BYTES, stream, a); } }
}
```
